# Optimizing an MI355X kernel written in HIP

```python
import math
import jax, jax.numpy as jnp
from jax import lax
import numpy as np

D_MODEL = 1024
BATCH = 16
SEQ = 4096
DEPTH = 4

MEM_LEN = 256
A_HEADS = 4
A_QK_DIM = 64
A_V_DIM = 2 * A_QK_DIM
B_HEADS = 4
B_HEAD_DIM = 64
DILATED_PATTERNS = ((128, 1), (512, 4), (2048, 16))
DILATED_BLK = 128
C_HEADS = 4
C_HEAD_DIM = 64
IDX_HEADS = 8
IDX_DIM = 64
TOPK_MAX = 256
IN_SPLITS = (
    A_HEADS * 2 * A_QK_DIM,
    A_HEADS * 2 * A_QK_DIM,
    A_HEADS * A_V_DIM,
    B_HEADS * B_HEAD_DIM,
    B_HEADS * B_HEAD_DIM,
    B_HEADS * B_HEAD_DIM,
    C_HEADS * C_HEAD_DIM,
    C_HEADS * C_HEAD_DIM,
    C_HEADS * C_HEAD_DIM,
    IDX_HEADS * IDX_DIM,
    IDX_DIM,
    IDX_HEADS,
)
N_IN = 3656
MIX_WIDTH = A_HEADS * A_V_DIM + B_HEADS * B_HEAD_DIM + C_HEADS * C_HEAD_DIM
REL_BUCKETS = 32
REL_MAX_DIST = 2048
N_BIAS_HEADS = A_HEADS + B_HEADS + C_HEADS
MEM_HEADS = 4
MEM_HEAD_DIM = D_MODEL // MEM_HEADS
D_FF = 2816
CONV_WIDTH = 3

Q_BLK = 128
EPS = 1e-6
NEG = -1e30

kernel_name = "hybrid_diff_dilated_dsa_trunk"


def rmsnorm(x, g):
    x32 = x.astype(jnp.float32)
    y = x32 * lax.rsqrt(jnp.mean(x32 * x32, axis=-1, keepdims=True) + EPS)
    return (y * g.astype(jnp.float32)).astype(x.dtype)


def rel_bucket(dist):
    n = jnp.maximum(dist, 0)
    max_exact = REL_BUCKETS // 2
    nf = jnp.maximum(n, 1).astype(jnp.float32)
    large = max_exact + (jnp.log(nf / max_exact) / math.log(REL_MAX_DIST / max_exact)
                         * (REL_BUCKETS - max_exact)).astype(jnp.int32)
    large = jnp.minimum(large, REL_BUCKETS - 1)
    return jnp.where(n < max_exact, n, large)


def diff_attention(q, k, v, lam, lam_init, subln_g, table):
    Bn, S, H, _, d = q.shape
    nb = S // Q_BLK
    scale = d ** -0.5
    kpos = jnp.arange(S, dtype=jnp.int32)
    v32 = v.astype(jnp.float32)

    def block(args):
        qb, start = args
        qpos = start + jnp.arange(Q_BLK, dtype=jnp.int32)
        s = jnp.einsum('bqhmd,bkhmd->bhmqk', qb, k).astype(jnp.float32) * scale
        dist = qpos[:, None] - kpos[None, :]
        bias = jnp.transpose(table[rel_bucket(dist)].astype(jnp.float32), (2, 0, 1))
        s = jnp.where(dist >= 0, s + bias[None, :, None], NEG)
        p = jax.nn.softmax(s, axis=-1)
        attn = p[:, :, 0] - lam * p[:, :, 1]
        return jnp.einsum('bhqk,bkhd->bqhd', attn, v32)

    qb = jnp.moveaxis(q.reshape(Bn, nb, Q_BLK, H, 2, d), 1, 0)
    starts = jnp.arange(nb, dtype=jnp.int32) * Q_BLK
    o = lax.map(block, (qb, starts))
    o = jnp.moveaxis(o, 0, 1).reshape(Bn, S, H, v.shape[-1])
    return rmsnorm(o, subln_g) * (1.0 - lam_init)


def dilated_branch(q, k, v, window, r, table, scale):
    Bn, S, H, d = q.shape
    n_back = window // r
    unit = r * DILATED_BLK
    S_pad = -(-S // unit) * unit
    nb = S_pad // unit
    pad = ((0, 0), (0, S_pad - S), (0, 0), (0, 0))
    qb = jnp.pad(q, pad).reshape(Bn, nb, DILATED_BLK, r, H, d)
    kb = jnp.pad(k, pad).reshape(Bn, nb, DILATED_BLK, r, H, d)
    vb = jnp.pad(v, pad).reshape(Bn, nb, DILATED_BLK, r, H, d)

    def with_prev(t):
        prev = jnp.pad(t, ((0, 0), (1, 0), (0, 0), (0, 0), (0, 0), (0, 0)))[:, :nb]
        return jnp.concatenate([prev, t], axis=2)

    kk = with_prev(kb)
    vv = with_prev(vb).astype(jnp.float32)
    s = jnp.einsum('bnqchd,bnkchd->bnchqk', qb, kk).astype(jnp.float32) * scale
    qi = jnp.arange(DILATED_BLK, dtype=jnp.int32)[:, None]
    ki = jnp.arange(2 * DILATED_BLK, dtype=jnp.int32)[None, :]
    dist_m = qi + DILATED_BLK - ki
    m_q = jnp.arange(nb, dtype=jnp.int32)[:, None, None] * DILATED_BLK + qi[None]
    mask = (dist_m >= 0) & (dist_m <= n_back) & (m_q - dist_m >= 0)
    bias = jnp.transpose(table[rel_bucket(dist_m * r)].astype(jnp.float32), (2, 0, 1))
    s = jnp.where(mask[None, :, None, None], s + bias, NEG)
    lse = jax.nn.logsumexp(s, axis=-1)
    p = jnp.exp(s - lse[..., None])
    o = jnp.einsum('bnchqk,bnkchd->bnqchd', p, vv).reshape(Bn, S_pad, H, d)[:, :S]
    lse = jnp.transpose(lse, (0, 1, 4, 2, 3)).reshape(Bn, S_pad, H)[:, :S]
    return o, lse


def dilated_attention(q, k, v, table):
    scale = q.shape[-1] ** -0.5
    outs, lses = [], []
    for window, r in DILATED_PATTERNS:
        o, lse = dilated_branch(q, k, v, window, r, table, scale)
        outs.append(o)
        lses.append(lse)
    wts = jax.nn.softmax(jnp.stack(lses, 0), axis=0)
    return jnp.einsum('pbsh,pbshd->bshd', wts, jnp.stack(outs, 0))


def dsa_attention(q, k, v, iq, ik, iw, table):
    Bn, S, H, d = q.shape
    nb = S // Q_BLK
    topk = min(TOPK_MAX, S // 4)
    scale = d ** -0.5
    kpos = jnp.arange(S, dtype=jnp.int32)
    iw = iw.astype(jnp.float32) * (IDX_HEADS ** -0.5)

    def block(args):
        qb, iqb, iwb, start = args
        qpos = start + jnp.arange(Q_BLK, dtype=jnp.int32)
        logits = jnp.einsum('bqhd,bkd->bqhk', iqb, ik).astype(jnp.float32) * (IDX_DIM ** -0.5)
        score = jnp.einsum('bqhk,bqh->bqk', jax.nn.relu(logits), iwb)
        score = jnp.where(kpos[None, None, :] <= qpos[None, :, None], score, NEG)
        _, idx = lax.top_k(score, topk)
        valid = idx <= qpos[None, :, None]
        flat = idx.reshape(Bn, Q_BLK * topk)
        ks = jax.vmap(lambda kb, ib: kb[ib])(k, flat).reshape(Bn, Q_BLK, topk, H, d)
        vs = jax.vmap(lambda vb, ib: vb[ib])(v, flat).reshape(Bn, Q_BLK, topk, H, d)
        s = jnp.einsum('bqhd,bqkhd->bhqk', qb, ks).astype(jnp.float32) * scale
        bias = jnp.transpose(table[rel_bucket(qpos[None, :, None] - idx)].astype(jnp.float32), (0, 3, 1, 2))
        s = jnp.where(valid[:, None], s + bias, NEG)
        p = jax.nn.softmax(s, axis=-1)
        return jnp.einsum('bhqk,bqkhd->bqhd', p, vs.astype(jnp.float32))

    qb = jnp.moveaxis(q.reshape(Bn, nb, Q_BLK, H, d), 1, 0)
    iqb = jnp.moveaxis(iq.reshape(Bn, nb, Q_BLK, IDX_HEADS, IDX_DIM), 1, 0)
    iwb = jnp.moveaxis(iw.reshape(Bn, nb, Q_BLK, IDX_HEADS), 1, 0)
    starts = jnp.arange(nb, dtype=jnp.int32) * Q_BLK
    o = lax.map(block, (qb, iqb, iwb, starts))
    return jnp.moveaxis(o, 0, 1).reshape(Bn, S, H, d)


def hybrid_mixer(h, w_in, lam_q1, lam_k1, lam_q2, lam_k2, subln_g, w_out, rel_bias, layer_idx):
    Bn, S, _ = h.shape
    proj = h @ w_in
    (aq, ak, av, bq, bk, bv, cq, ck, cv, iq, ik, iw) = jnp.split(
        proj, np.cumsum(IN_SPLITS)[:-1].tolist(), axis=-1)
    lam_init = 0.8 - 0.6 * math.exp(-0.3 * layer_idx)
    lam = (jnp.exp(jnp.sum(lam_q1.astype(jnp.float32) * lam_k1.astype(jnp.float32)))
           - jnp.exp(jnp.sum(lam_q2.astype(jnp.float32) * lam_k2.astype(jnp.float32))) + lam_init)
    o_a = diff_attention(aq.reshape(Bn, S, A_HEADS, 2, A_QK_DIM), ak.reshape(Bn, S, A_HEADS, 2, A_QK_DIM),
                         av.reshape(Bn, S, A_HEADS, A_V_DIM), lam, lam_init, subln_g,
                         rel_bias[:, :A_HEADS])
    o_b = dilated_attention(bq.reshape(Bn, S, B_HEADS, B_HEAD_DIM), bk.reshape(Bn, S, B_HEADS, B_HEAD_DIM),
                            bv.reshape(Bn, S, B_HEADS, B_HEAD_DIM),
                            rel_bias[:, A_HEADS:A_HEADS + B_HEADS])
    o_c = dsa_attention(cq.reshape(Bn, S, C_HEADS, C_HEAD_DIM), ck.reshape(Bn, S, C_HEADS, C_HEAD_DIM),
                        cv.reshape(Bn, S, C_HEADS, C_HEAD_DIM), iq.reshape(Bn, S, IDX_HEADS, IDX_DIM),
                        ik, iw, rel_bias[:, A_HEADS + B_HEADS:])
    o = jnp.concatenate([o_a.reshape(Bn, S, -1), o_b.reshape(Bn, S, -1), o_c.reshape(Bn, S, -1)],
                        axis=-1).astype(h.dtype)
    return o @ w_out


def memory_attention(h, mem_n, w_mq, w_mkv, w_mo):
    Bn, S, D = h.shape
    q = (h @ w_mq).reshape(Bn, S, MEM_HEADS, MEM_HEAD_DIM)
    k, v = jnp.split(mem_n @ w_mkv, 2, axis=-1)
    k = k.reshape(Bn, -1, MEM_HEADS, MEM_HEAD_DIM)
    v = v.reshape(Bn, -1, MEM_HEADS, MEM_HEAD_DIM)
    s = jnp.einsum('bqhd,bkhd->bhqk', q, k).astype(jnp.float32) * (MEM_HEAD_DIM ** -0.5)
    p = jax.nn.softmax(s, axis=-1)
    o = jnp.einsum('bhqk,bkhd->bqhd', p, v.astype(jnp.float32)).astype(h.dtype).reshape(Bn, S, D)
    return o @ w_mo


def conv_ffn(h, w_up, conv_w, conv_b, w_down):
    S = h.shape[1]
    u = h @ w_up
    u_p = jnp.pad(u, ((0, 0), (CONV_WIDTH - 1, 0), (0, 0)))
    c = conv_b
    for j in range(CONV_WIDTH):
        c = c + conv_w[j] * u_p[:, j:j + S]
    gate, val = jnp.split(c, 2, axis=-1)
    return (jax.nn.silu(gate) * val) @ w_down


def setup_inputs(seed: int = 0) -> dict:
    key = jax.random.key(seed)
    ks = jax.random.split(key, 24)

    def nrm(k, shape, scale):
        return jax.random.normal(k, shape, jnp.float32) * scale

    L, D, F = DEPTH, D_MODEL, D_FF
    return {
        "x": nrm(ks[0], (BATCH, SEQ, D), 1.0),
        "mem": nrm(ks[1], (BATCH, MEM_LEN, D), 1.0),
        "rel_bias": nrm(ks[2], (REL_BUCKETS, N_BIAS_HEADS), 0.2),
        "norm_mix": 1.0 + nrm(ks[3], (L, D), 0.1),
        "w_in": nrm(ks[4], (L, D, N_IN), D ** -0.5),
        "lam_q1": nrm(ks[5], (L, A_QK_DIM), 0.1),
        "lam_k1": nrm(ks[6], (L, A_QK_DIM), 0.1),
        "lam_q2": nrm(ks[7], (L, A_QK_DIM), 0.1),
        "lam_k2": nrm(ks[8], (L, A_QK_DIM), 0.1),
        "subln": 1.0 + nrm(ks[9], (L, A_V_DIM), 0.1),
        "w_out": nrm(ks[10], (L, MIX_WIDTH, D), MIX_WIDTH ** -0.5),
        "norm_mem": 1.0 + nrm(ks[11], (L, D), 0.1),
        "norm_memkv": 1.0 + nrm(ks[12], (L, D), 0.1),
        "w_mq": nrm(ks[13], (L, D, D), D ** -0.5),
        "w_mkv": nrm(ks[14], (L, D, 2 * D), D ** -0.5),
        "w_mo": nrm(ks[15], (L, D, D), D ** -0.5),
        "norm_ffn": 1.0 + nrm(ks[16], (L, D), 0.1),
        "w_up": nrm(ks[17], (L, D, 2 * F), D ** -0.5),
        "conv_w": nrm(ks[18], (L, CONV_WIDTH, 2 * F), CONV_WIDTH ** -0.5),
        "conv_b": nrm(ks[19], (L, 2 * F), 0.02),
        "w_down": nrm(ks[20], (L, F, D), F ** -0.5),
        "norm_final": 1.0 + nrm(ks[21], (D,), 0.1),
    }


def reference(x, mem, rel_bias, norm_mix, w_in, lam_q1, lam_k1, lam_q2, lam_k2, subln, w_out,
              norm_mem, norm_memkv, w_mq, w_mkv, w_mo, norm_ffn, w_up, conv_w, conv_b, w_down,
              norm_final):
    for l in range(DEPTH):
        h = rmsnorm(x, norm_mix[l])
        x = x + hybrid_mixer(h, w_in[l], lam_q1[l], lam_k1[l], lam_q2[l], lam_k2[l], subln[l],
                             w_out[l], rel_bias, l)
        h = rmsnorm(x, norm_mem[l])
        x = x + memory_attention(h, rmsnorm(mem, norm_memkv[l]), w_mq[l], w_mkv[l], w_mo[l])
        h = rmsnorm(x, norm_ffn[l])
        x = x + conv_ffn(h, w_up[l], conv_w[l], conv_b[l], w_down[l])
    return rmsnorm(x, norm_final)
```

```cpp
#include <hip/hip_runtime.h>
#include <hip/hip_cooperative_groups.h>
#include <cstdio>
#include <cstdint>
namespace cg = cooperative_groups;

namespace pg8 {
#define PG8_LAS __attribute__((address_space(3)))
typedef unsigned short bf16_t;
typedef short bf16x8 __attribute__((ext_vector_type(8)));
typedef float f32x4 __attribute__((ext_vector_type(4)));
typedef unsigned u32x4 __attribute__((ext_vector_type(4)));
constexpr int BM = 256, BK = 64, HALF = 128, HTB = HALF * BK * 2  , STAGE_BYTES = 8 * HTB, NXCD = 8, WGM = 8;

__host__ __device__ __forceinline__ int lds_byte(int r, int c) { const int st = (r >> 4) * 2 + (c >> 5), rr = r & 15, cc = c & 31, ob = rr * 64 + cc * 2; return st * 1024 + (ob ^ (((ob >> 9) & 1) << 5)); }
__host__ __device__ __forceinline__ void stage_rc(int b, int& R, int& C) { const int st = b / 1024, sb = b % 1024, swz = sb ^ (((sb >> 9) & 1) << 5); R = (st >> 1) * 16 + swz / 64; C = (st & 1) * 32 + (swz % 64) / 2; }
__host__ __device__ __forceinline__ int perm32(int rho) { const int n = rho >> 4, i = rho & 15; return 8 * (i >> 2) + 4 * n + (i & 3); }

struct Unit { int pm, pn; };
struct Gemm { const bf16_t* A; const bf16_t* Bt; int M, N, K; };

struct StaticOrder {
    int nM, nN, nwg, G, c;
    __host__ __device__ void init(int M, int N, int G_, int c_) { nM = M / BM; nN = N / BM; nwg = nM * nN; G = G_; c = c_; }
    __host__ __device__ bool next(int i, Unit& u) const {
        const long L = (long)i * G + c; if (L >= nwg) return false;
        int wgid = (int)L; { const int q = nwg / NXCD, r = nwg % NXCD, xcd = wgid % NXCD, off = wgid / NXCD; wgid = (xcd < r ? xcd * (q + 1) : r * (q + 1) + (xcd - r) * q) + off; }
        const int nig = WGM * nN, gid = wgid / nig, fm = gid * WGM, gsz = (nM - fm) < WGM ? (nM - fm) : WGM;
        u.pm = fm + ((wgid % nig) % gsz); u.pn = (wgid % nig) / gsz; return true;
    }
    __device__ __forceinline__ void a_ready(const Unit&) const {}
    __device__ __forceinline__ void done(const Unit&) const {}
};

__device__ __forceinline__ unsigned cvt_pk_bf16(float lo, float hi) { unsigned r; asm volatile("v_cvt_pk_bf16_f32 %0, %1, %2" : "=v"(r) : "v"(lo), "v"(hi)); return r; }
__device__ __forceinline__ void load_row_scales(const float* ssp, int row0, int fq, float (&rs)[2][4]) {
    f32x4 part[2][4];
    const float* sp = ssp + (size_t)row0 * 16 + 4 * fq;
#pragma unroll
    for (int ai = 0; ai < 2; ++ai)
#pragma unroll
        for (int m = 0; m < 4; ++m) part[ai][m] = *(const f32x4*)(sp + (size_t)(ai * HALF + m * 16) * 16);
#pragma unroll
    for (int ai = 0; ai < 2; ++ai)
#pragma unroll
        for (int m = 0; m < 4; ++m) { float t = (part[ai][m][0] + part[ai][m][1]) + (part[ai][m][2] + part[ai][m][3]);
            t += __shfl_xor(t, 16); t += __shfl_xor(t, 32);
            rs[ai][m] = 1.0f / sqrtf(t * (1.0f / 1024.0f) + 1e-6f); }
}
struct EpiStore {
    static constexpr bool PERM = true, AFTER_DRAIN = false;
    bf16_t* R; int ldr; int r_col0; bf16_t* T; int ldt; int t_lo, t_hi, t_col0; const float* ssp;
    __device__ __forceinline__ float row_rs(const float* sp) const {
        const f32x4 a = *(const f32x4*)sp, b = *(const f32x4*)(sp + 4), c = *(const f32x4*)(sp + 8), d = *(const f32x4*)(sp + 12);
        const float tot = ((a[0] + a[1]) + (a[2] + a[3])) + ((b[0] + b[1]) + (b[2] + b[3])) + ((c[0] + c[1]) + (c[2] + c[3])) + ((d[0] + d[1]) + (d[2] + d[3]));
        return 1.0f / sqrtf(tot * (1.0f / 1024.0f) + 1e-6f);
    }
    __device__ __forceinline__ void operator()(f32x4 (&acc)[2][2][4][2], const Unit& u, int wr, int wc, int fr, int fq) const {
        const int row0 = u.pm * BM + wr * 64 + fr;
        const int colt = u.pn * BM + wc * 32 + 8 * fq;
        if (u.pn >= t_lo && u.pn < t_hi) {
            if (ssp) { float rs[2][4]; load_row_scales(ssp, row0, fq, rs);
#pragma unroll
                for (int ai = 0; ai < 2; ++ai)
#pragma unroll
                    for (int m = 0; m < 4; ++m)
#pragma unroll
                        for (int bj = 0; bj < 2; ++bj)
#pragma unroll
                            for (int n = 0; n < 2; ++n) acc[ai][bj][m][n] = acc[ai][bj][m][n] * rs[ai][m];
            }
            bf16_t* tp = T + (size_t)(colt - t_col0) * ldt + row0;
#pragma unroll
            for (int bj = 0; bj < 2; ++bj) {
#pragma unroll
                for (int n = 0; n < 2; ++n)
#pragma unroll
                    for (int j = 0; j < 4; ++j) {
#pragma unroll
                        for (int ai = 0; ai < 2; ++ai)
#pragma unroll
                            for (int m = 0; m < 4; ++m) tp[ai * HALF + m * 16] = (bf16_t)(cvt_pk_bf16(acc[ai][bj][m][n][j], 0.f) & 0xffffu);
                        tp += ldt; asm volatile("" : "+v"(tp)); }
                tp += (size_t)120 * ldt; asm volatile("" : "+v"(tp)); }
        } else {
            bf16_t* rowp = R + (size_t)row0 * ldr + (colt - r_col0);
            float rsa[2][4];
            if (ssp) load_row_scales(ssp, row0, fq, rsa);
            else {
#pragma unroll
                for (int ai = 0; ai < 2; ++ai)
#pragma unroll
                    for (int m = 0; m < 4; ++m) rsa[ai][m] = 1.0f; }
#pragma unroll
            for (int ai = 0; ai < 2; ++ai) {
#pragma unroll
                for (int m = 0; m < 4; ++m) { const float rs = rsa[ai][m];
#pragma unroll
                    for (int bj = 0; bj < 2; ++bj) { const f32x4 v0 = acc[ai][bj][m][0] * rs, v1 = acc[ai][bj][m][1] * rs;
                        u32x4 w; w.x = cvt_pk_bf16(v0[0], v0[1]); w.y = cvt_pk_bf16(v0[2], v0[3]); w.z = cvt_pk_bf16(v1[0], v1[1]); w.w = cvt_pk_bf16(v1[2], v1[3]);
                        *(u32x4*)(rowp + bj * HALF) = w; }
                    rowp += (size_t)16 * ldr; asm volatile("" : "+v"(rowp) :: "memory"); }
                rowp += (size_t)64 * ldr; asm volatile("" : "+v"(rowp)); }
        }
    }
};
struct EpiResid {
    static constexpr bool PERM = false, AFTER_DRAIN = false;
    bf16_t* xb; int ldc; float* ssp;
    __device__ __forceinline__ void operator()(f32x4 (&acc)[2][2][4][2], const Unit& u, int wr, int wc, int fr, int fq) const {
        const int col0 = u.pn * BM + wc * 32 + 4 * fq;
#pragma unroll
        for (int ai = 0; ai < 2; ++ai) {
            unsigned long long old[4][2][2];
#pragma unroll
            for (int m = 0; m < 4; ++m) { const size_t off = (size_t)(u.pm * BM + ai * HALF + wr * 64 + m * 16 + fr) * ldc + col0;
#pragma unroll
                for (int bj = 0; bj < 2; ++bj)
#pragma unroll
                    for (int n = 0; n < 2; ++n) old[m][bj][n] = *(const unsigned long long*)(xb + off + bj * HALF + n * 16); }
#pragma unroll
            for (int m = 0; m < 4; ++m) { const int row = u.pm * BM + ai * HALF + wr * 64 + m * 16 + fr; const size_t off = (size_t)row * ldc + col0; float sq = 0.f;
#pragma unroll
                for (int bj = 0; bj < 2; ++bj)
#pragma unroll
                    for (int n = 0; n < 2; ++n) { const unsigned long long b = old[m][bj][n];
                        const unsigned blo = (unsigned)b, bhi = (unsigned)(b >> 32);
                        f32x4 v; v[0] = __builtin_bit_cast(float, blo << 16); v[1] = __builtin_bit_cast(float, blo & 0xffff0000u); v[2] = __builtin_bit_cast(float, bhi << 16); v[3] = __builtin_bit_cast(float, bhi & 0xffff0000u);
                        v = v + acc[ai][bj][m][n];
                        sq += (v[0] * v[0] + v[1] * v[1]) + (v[2] * v[2] + v[3] * v[3]);
                        *(unsigned long long*)(xb + off + bj * HALF + n * 16) = (unsigned long long)cvt_pk_bf16(v[0], v[1]) | ((unsigned long long)cvt_pk_bf16(v[2], v[3]) << 32); }
                sq += __shfl_xor(sq, 16); sq += __shfl_xor(sq, 32);
                if (fq == 0) ssp[(size_t)row * 16 + 4 * u.pn + wc] = sq; }
            asm volatile("" ::: "memory"); }
    }
};
__device__ __forceinline__ float dppf(float old, float src, int ctrl_sel) {
    const int o = __builtin_bit_cast(int, old), v = __builtin_bit_cast(int, src); int r;
    if (ctrl_sel == 0) r = __builtin_amdgcn_update_dpp(o, v, 0x111, 0xf, 0xf, false);
    else if (ctrl_sel == 1) r = __builtin_amdgcn_update_dpp(o, v, 0x112, 0xf, 0xf, false);
    else if (ctrl_sel == 2) r = __builtin_amdgcn_update_dpp(o, v, 0x121, 0xf, 0xf, false);
    else r = __builtin_amdgcn_update_dpp(o, v, 0x122, 0xf, 0xf, false);
    return __builtin_bit_cast(float, r);
}
struct EpiConv {
    static constexpr bool PERM = true, AFTER_DRAIN = false;
    bf16_t* G; bf16_t* Fb; bf16_t* Hb; const float* cw; const float* cb; const float* ssp;
    __device__ __forceinline__ void operator()(f32x4 (&acc)[2][2][4][2], const Unit& u, int wr, int wc, int fr, int fq) const {
        constexpr int FFc = 2816, FF2c = 5632;
        const int row0 = u.pm * BM + wr * 64 + fr;
        { float rs[2][4]; load_row_scales(ssp, row0, fq, rs);
#pragma unroll
          for (int ai = 0; ai < 2; ++ai)
#pragma unroll
              for (int m = 0; m < 4; ++m)
#pragma unroll
                  for (int bj = 0; bj < 2; ++bj)
#pragma unroll
                      for (int n = 0; n < 2; ++n) acc[ai][bj][m][n] = acc[ai][bj][m][n] * rs[ai][m]; }
#pragma unroll
        for (int n = 0; n < 2; ++n) {
            const int gc0 = u.pn * 128 + wc * 32 + 8 * fq + 4 * n;
            const float* cwp = cw + gc0; asm volatile("" : "+v"(cwp));
            const f32x4 wg0 = *(const f32x4*)(cwp), wg1 = *(const f32x4*)(cwp + FF2c), wg2 = *(const f32x4*)(cwp + 2 * FF2c);
            const f32x4 wv0 = *(const f32x4*)(cwp + FFc), wv1 = *(const f32x4*)(cwp + FF2c + FFc), wv2 = *(const f32x4*)(cwp + 2 * FF2c + FFc);
            const f32x4 bg = *(const f32x4*)(cb + gc0), bv = *(const f32x4*)(cb + FFc + gc0);
            bf16_t* gp = G + (size_t)row0 * FFc + gc0;
            bf16_t* sb = Fb + ((size_t)(row0 >> 6) * 2 + (fr & 1)) * FF2c + gc0;
            bf16_t* hb = Hb + ((size_t)(row0 >> 6) * 2 + (fr & 1)) * FF2c + gc0;
#pragma unroll
            for (int ai = 0; ai < 2; ++ai) {
#pragma unroll
                for (int m = 0; m < 4; ++m) {
                    float og[4];
#pragma unroll
                    for (int j = 0; j < 4; ++j) {
                        const float vg = acc[ai][0][m][n][j], vv = acc[ai][1][m][n][j];
                        const float pg = (m > 0) ? acc[ai][0][m - 1][n][j] : 0.f, pv = (m > 0) ? acc[ai][1][m - 1][n][j] : 0.f;
                        const float g1 = dppf(dppf(0.f, pg, 2), vg, 0), g2 = dppf(dppf(0.f, pg, 3), vg, 1);
                        const float v1 = dppf(dppf(0.f, pv, 2), vv, 0), v2 = dppf(dppf(0.f, pv, 3), vv, 1);
                        const float cgate = bg[j] + wg0[j] * g2 + wg1[j] * g1 + wg2[j] * vg;
                        const float cval = bv[j] + wv0[j] * v2 + wv1[j] * v1 + wv2[j] * vv;
                        og[j] = cgate * __builtin_amdgcn_rcpf(1.0f + __builtin_amdgcn_exp2f(-1.4426950408889634f * cgate)) * cval; }
                    const unsigned long long w = (unsigned long long)cvt_pk_bf16(og[0], og[1]) | ((unsigned long long)cvt_pk_bf16(og[2], og[3]) << 32);
                    if (m == 0) {
                        if (fr >= 2) *(unsigned long long*)gp = w;
                        else { *(unsigned long long*)sb = (unsigned long long)cvt_pk_bf16(acc[ai][0][0][n][0], acc[ai][0][0][n][1]) | ((unsigned long long)cvt_pk_bf16(acc[ai][0][0][n][2], acc[ai][0][0][n][3]) << 32);
                               *(unsigned long long*)(sb + FFc) = (unsigned long long)cvt_pk_bf16(acc[ai][1][0][n][0], acc[ai][1][0][n][1]) | ((unsigned long long)cvt_pk_bf16(acc[ai][1][0][n][2], acc[ai][1][0][n][3]) << 32); }
                    } else *(unsigned long long*)gp = w;
                    if (m == 3 && fr >= 14) {
                        *(unsigned long long*)hb = (unsigned long long)cvt_pk_bf16(acc[ai][0][3][n][0], acc[ai][0][3][n][1]) | ((unsigned long long)cvt_pk_bf16(acc[ai][0][3][n][2], acc[ai][0][3][n][3]) << 32);
                        *(unsigned long long*)(hb + FFc) = (unsigned long long)cvt_pk_bf16(acc[ai][1][3][n][0], acc[ai][1][3][n][1]) | ((unsigned long long)cvt_pk_bf16(acc[ai][1][3][n][2], acc[ai][1][3][n][3]) << 32); }
                    gp += (size_t)16 * FFc; asm volatile("" : "+v"(gp) :: "memory"); }
                gp += (size_t)64 * FFc; sb += (size_t)4 * FF2c; hb += (size_t)4 * FF2c; asm volatile("" : "+v"(gp), "+v"(sb), "+v"(hb)); }
        }
    }
};

template <class Epi, class Sched, bool ALIGN_EPI = false, bool SP2 = false>
__device__ __forceinline__ void gemm_phase(PG8_LAS unsigned char* lds, const Gemm g, const Sched& S, const Epi& E) {
    int tid_o = threadIdx.x; asm volatile("" : "+v"(tid_o));
    const int tid = tid_o, wid = __builtin_amdgcn_readfirstlane(tid >> 6), lane = tid & 63, wr = wid >> 2, wc = wid & 3, fr = lane & 15, fq = lane >> 4;
    const int K = g.K, nt = K / BK;
    unsigned voffA[2], voffB[2];
#pragma unroll
    for (int i = 0; i < 2; ++i) { int R, C; stage_rc(tid * 16 + i * 8192, R, C); const int Rb = Epi::PERM ? ((R & ~31) + perm32(R & 31)) : R;
        voffA[i] = (unsigned)(R * K + C) * 2u; voffB[i] = (unsigned)(Rb * K + C) * 2u; }
    const size_t kstep = (size_t)(BK * 2);
    const size_t hstep = (size_t)HALF * K * 2;
    const size_t tstep = 2 * hstep;
    const unsigned ldsw = (unsigned)wid * 1024u;
    const int aoff = lds_byte(wr * 64 + fr, fq * 8), boff = lds_byte(wc * 32 + fr, fq * 8);
#define PG8_SA(b, h) (((b) * 2 + (h)) * HTB)
#define PG8_SB(b, h) ((4 + (b) * 2 + (h)) * HTB)
#define PG8_STAGE(bufoff, gbase, voff) do { _Pragma("unroll") for (int _i = 0; _i < 2; ++_i) \
        __builtin_amdgcn_global_load_lds((const unsigned*)((const char*)(gbase) + (voff)[_i]), (PG8_LAS unsigned*)(lds + (bufoff) + ldsw + _i * 8192), 16, 0, 0); } while (0)
#define PG8_LDA(dst, b, h) do { _Pragma("unroll") for (int m = 0; m < 4; ++m) _Pragma("unroll") for (int k = 0; k < 2; ++k) dst[m][k] = *(const PG8_LAS bf16x8*)(lds + PG8_SA(b, h) + aoff + m * 2048 + k * 1024); } while (0)
#define PG8_LDB(dst, b, h) do { _Pragma("unroll") for (int n = 0; n < 2; ++n) _Pragma("unroll") for (int k = 0; k < 2; ++k) dst[n][k] = *(const PG8_LAS bf16x8*)(lds + PG8_SB(b, h) + boff + n * 2048 + k * 1024); } while (0)
#define PG8_MMA(ai, bj, At, Bt) do { __builtin_amdgcn_s_setprio(1); _Pragma("unroll") for (int m = 0; m < 4; ++m) _Pragma("unroll") for (int n = 0; n < 2; ++n) _Pragma("unroll") for (int k = 0; k < 2; ++k) \
        acc[ai][bj][m][n] = __builtin_amdgcn_mfma_f32_16x16x32_bf16(Bt[n][k], At[m][k], acc[ai][bj][m][n], 0, 0, 0); __builtin_amdgcn_s_setprio(0); } while (0)
#define PG8_WAIT_V(n) asm volatile("s_waitcnt vmcnt(" #n ")" ::: "memory")
#define PG8_WAIT_L(n) asm volatile("s_waitcnt lgkmcnt(" #n ")" ::: "memory")
#define PG8_BAR __builtin_amdgcn_s_barrier()
#define PG8_SCHED __builtin_amdgcn_sched_barrier(0)
    Unit cur, nxt; int ui = 0;
    if (!S.next(0, cur)) return;
    f32x4 acc[2][2][4][2];
#pragma unroll
    for (int a = 0; a < 2; ++a)
#pragma unroll
        for (int b = 0; b < 2; ++b)
#pragma unroll
            for (int m = 0; m < 4; ++m)
#pragma unroll
                for (int n = 0; n < 2; ++n) acc[a][b][m][n] = (f32x4){0.f, 0.f, 0.f, 0.f};
    bf16x8 At[4][2], B0[2][2], B1[2][2];
    const char* cA = (const char*)g.A + (size_t)cur.pm * tstep; const char* cB = (const char*)g.Bt + (size_t)cur.pn * tstep;
    S.a_ready(cur);
    if constexpr (SP2) {
        PG8_STAGE(PG8_SB(0, 0), cB, voffB); PG8_STAGE(PG8_SB(0, 1), cB + hstep, voffB); PG8_STAGE(PG8_SA(0, 0), cA, voffA); PG8_STAGE(PG8_SA(0, 1), cA + hstep, voffA);
        if (wr == 1) PG8_BAR;
        PG8_WAIT_V(2); PG8_BAR;
        PG8_STAGE(PG8_SB(1, 0), cB + kstep, voffB); PG8_STAGE(PG8_SA(1, 0), cA + kstep, voffA); PG8_STAGE(PG8_SB(1, 1), cB + hstep + kstep, voffB);
        PG8_WAIT_V(6); PG8_BAR;
    } else {
        PG8_STAGE(PG8_SB(0, 0), cB, voffB); PG8_STAGE(PG8_SA(0, 0), cA, voffA); PG8_STAGE(PG8_SB(0, 1), cB + hstep, voffB); PG8_STAGE(PG8_SA(0, 1), cA + hstep, voffA);
        if (wr == 1) PG8_BAR;
        PG8_WAIT_V(4); PG8_BAR;
        PG8_STAGE(PG8_SB(1, 0), cB + kstep, voffB); PG8_STAGE(PG8_SA(1, 0), cA + kstep, voffA); PG8_STAGE(PG8_SB(1, 1), cB + hstep + kstep, voffB);
        PG8_WAIT_V(6); PG8_BAR;
    }
    for (;;) {
        const bool has_next = S.next(ui + 1, nxt);
        const char* nA = has_next ? (const char*)g.A + (size_t)nxt.pm * tstep : cA; const char* nB = has_next ? (const char*)g.Bt + (size_t)nxt.pn * tstep : cB;
        for (int t = 0; t < nt; t += 2) {
            const bool last = (t == nt - 2);
            const char* a1 = cA + (size_t)(t + 1) * kstep;
            const char* a2 = last ? nA : cA + (size_t)(t + 2) * kstep; const char* b2 = last ? nB : cB + (size_t)(t + 2) * kstep;
            const char* a3 = a2 + kstep; const char* b3 = b2 + kstep;
            if (last && has_next) S.a_ready(nxt);
            if constexpr (SP2) {
            PG8_LDB(B0, 0, 0); PG8_LDB(B1, 0, 1); PG8_SCHED; PG8_LDA(At, 0, 0); PG8_STAGE(PG8_SA(1, 1), a1 + hstep, voffA);
            PG8_WAIT_V(8); PG8_WAIT_L(0); PG8_BAR; PG8_MMA(0, 0, At, B0); PG8_MMA(0, 1, At, B1); PG8_BAR; PG8_SCHED;
            PG8_LDA(At, 0, 1); PG8_STAGE(PG8_SB(0, 0), b2, voffB); PG8_STAGE(PG8_SB(0, 1), b2 + hstep, voffB); PG8_STAGE(PG8_SA(0, 0), a2, voffA);
            PG8_WAIT_V(8); PG8_WAIT_L(0); PG8_BAR; PG8_MMA(1, 0, At, B0); PG8_MMA(1, 1, At, B1); PG8_BAR; PG8_SCHED;
            PG8_LDB(B0, 1, 0); PG8_LDB(B1, 1, 1); PG8_SCHED; PG8_LDA(At, 1, 0); PG8_STAGE(PG8_SA(0, 1), a2 + hstep, voffA);
            PG8_WAIT_V(8); PG8_WAIT_L(0); PG8_BAR; PG8_MMA(0, 0, At, B0); PG8_MMA(0, 1, At, B1); PG8_BAR; PG8_SCHED;
            PG8_LDA(At, 1, 1); PG8_STAGE(PG8_SB(1, 0), b3, voffB); PG8_STAGE(PG8_SB(1, 1), b3 + hstep, voffB); PG8_STAGE(PG8_SA(1, 0), a3, voffA);
            PG8_WAIT_V(8); PG8_WAIT_L(0); PG8_BAR; PG8_MMA(1, 0, At, B0); PG8_MMA(1, 1, At, B1); PG8_BAR; PG8_SCHED;
            } else {
            PG8_LDB(B0, 0, 0); PG8_SCHED; PG8_LDA(At, 0, 0); PG8_STAGE(PG8_SA(1, 1), a1 + hstep, voffA);
            PG8_WAIT_L(8); PG8_BAR; PG8_WAIT_L(0); PG8_MMA(0, 0, At, B0); PG8_BAR; PG8_SCHED;
            PG8_LDB(B1, 0, 1); PG8_STAGE(PG8_SB(0, 0), b2, voffB);
            PG8_BAR; PG8_WAIT_L(0); PG8_MMA(0, 1, At, B1); PG8_BAR;
            PG8_LDA(At, 0, 1); PG8_STAGE(PG8_SA(0, 0), a2, voffA);
            PG8_BAR; PG8_WAIT_L(0); PG8_MMA(1, 0, At, B0); PG8_BAR; PG8_SCHED;
            PG8_STAGE(PG8_SB(0, 1), b2 + hstep, voffB);
            PG8_WAIT_V(6); PG8_BAR; PG8_MMA(1, 1, At, B1); PG8_BAR;
            PG8_LDB(B0, 1, 0); PG8_SCHED; PG8_LDA(At, 1, 0); PG8_STAGE(PG8_SA(0, 1), a2 + hstep, voffA);
            PG8_WAIT_L(8); PG8_BAR; PG8_WAIT_L(0); PG8_MMA(0, 0, At, B0); PG8_BAR; PG8_SCHED;
            PG8_LDB(B1, 1, 1); PG8_STAGE(PG8_SB(1, 0), b3, voffB);
            PG8_BAR; PG8_WAIT_L(0); PG8_MMA(0, 1, At, B1); PG8_BAR;
            PG8_LDA(At, 1, 1); PG8_STAGE(PG8_SA(1, 0), a3, voffA);
            PG8_BAR; PG8_WAIT_L(0); PG8_MMA(1, 0, At, B0); PG8_BAR; PG8_SCHED;
            PG8_STAGE(PG8_SB(1, 1), b3 + hstep, voffB);
            PG8_WAIT_V(6); PG8_BAR; PG8_MMA(1, 1, At, B1); PG8_BAR;
            }
        }
        if constexpr (ALIGN_EPI) { if (wr == 0) PG8_BAR; }
        if constexpr (!Epi::AFTER_DRAIN) { E(acc, cur, wr, wc, fr, fq); S.done(cur); }
        if (!has_next) break;
#pragma unroll
        for (int a = 0; a < 2; ++a)
#pragma unroll
            for (int b = 0; b < 2; ++b)
#pragma unroll
                for (int m = 0; m < 4; ++m)
#pragma unroll
                    for (int n = 0; n < 2; ++n) acc[a][b][m][n] = (f32x4){0.f, 0.f, 0.f, 0.f};
        cur = nxt; cA = nA; cB = nB; ++ui;
        if constexpr (ALIGN_EPI) { if (wr == 1) PG8_BAR; }
    }
    PG8_WAIT_V(0);
    if constexpr (!ALIGN_EPI) { if (wr == 0) PG8_BAR; }
    PG8_BAR;
    if constexpr (Epi::AFTER_DRAIN) { E.fused(acc, cur, wr, wc, fr, fq, lds, wid, lane); S.done(cur); }
#undef PG8_SA
#undef PG8_SB
#undef PG8_STAGE
#undef PG8_LDA
#undef PG8_LDB
#undef PG8_MMA
#undef PG8_WAIT_V
#undef PG8_WAIT_L
#undef PG8_BAR
#undef PG8_SCHED
}
}

#define LAS __attribute__((address_space(3)))
using pg8::bf16_t;
typedef short bf16x8 __attribute__((ext_vector_type(8)));
typedef short s16x4 __attribute__((ext_vector_type(4)));
typedef float f32x16 __attribute__((ext_vector_type(16)));
typedef float f32x4 __attribute__((ext_vector_type(4)));
typedef float f32x2_t __attribute__((ext_vector_type(2)));
typedef __bf16 bf16x2_t __attribute__((ext_vector_type(2)));
typedef unsigned u32x4v __attribute__((ext_vector_type(4)));
typedef unsigned u32x2v __attribute__((ext_vector_type(2)));

constexpr int NB = 16, SEQ = 4096, DM = 1024, MTOK = NB * SEQ, NLAYER = 4, MEMLEN = 256, MMEM = NB * MEMLEN;
constexpr int NIN = 3656, NINP = 3840, PW = 2816, FF = 2816, FF2 = 5632;
constexpr int P_AQ = 0, P_AK = 512, P_BQ = 1024, P_BK = 1280, P_CQ = 1536, P_CK = 1792, P_IQ = 2048, P_IK = 2560, P_IW = 2624;
constexpr int V_A = 0, V_B = 512, V_C = 768;
constexpr int TABN = 4352, TABOFF = 256;
constexpr float NEGV = -1.0e30f, LOG2E = 1.4426950408889634f, EPSN = 1e-6f;
constexpr int FCH = 2, FROWS = MTOK / FCH;

constexpr size_t MiB = (size_t)1 << 20;
constexpr size_t WS_LAM = 0, WS_BAR = 4096, WS_BAR_BYTES = 16384, WS_TAB = 65536, WS_WT = 2 * MiB;
constexpr size_t WT_IN = 0, WT_OUT = 30 * MiB, WT_MQ = 38 * MiB, WT_MO = 46 * MiB, WT_MKV = 54 * MiB, WT_UP = 70 * MiB, WT_DN = 114 * MiB;
constexpr size_t WS_XH = 138 * MiB, WS_MIX = 266 * MiB, WS_P = 394 * MiB, WS_VT = 746 * MiB, WS_BITS = 874 * MiB, WS_MEMK = 906 * MiB, WS_MEMVT = 938 * MiB, WS_MEMH = 970 * MiB, WS_STASH = 978 * MiB, WS_SS = 1010 * MiB, WS_END = 1022 * MiB;
constexpr size_t WS_G = WS_MIX, WS_FB = WS_MIX + 352 * MiB, WS_HB = WS_FB + 22 * MiB, WS_QM = WS_P;
constexpr int LDS_BYTES = 147456;

__device__ __forceinline__ unsigned cvtpk(float lo, float hi) { f32x2_t v = {lo, hi}; bf16x2_t b = __builtin_convertvector(v, bf16x2_t); return __builtin_bit_cast(unsigned, b); }
__device__ __forceinline__ float bf2f(bf16_t v) { return __builtin_bit_cast(float, (unsigned)v << 16); }
__device__ __forceinline__ float swap32_add(float v) { auto rr = __builtin_amdgcn_permlane32_swap(__float_as_uint(v), __float_as_uint(v), false, false); return __uint_as_float(rr[0]) + __uint_as_float(rr[1]); }
__device__ __forceinline__ float swap32_max(float v) { auto rr = __builtin_amdgcn_permlane32_swap(__float_as_uint(v), __float_as_uint(v), false, false); return fmaxf(__uint_as_float(rr[0]), __uint_as_float(rr[1])); }
__device__ __forceinline__ float max3f(float a, float b, float c) { float r; asm("v_max3_f32 %0, %1, %2, %3" : "=v"(r) : "v"(a), "v"(b), "v"(c)); return r; }
__device__ __forceinline__ float reluf(float a) { float r; asm("v_max_f32_e32 %0, 0, %1" : "=v"(r) : "v"(a)); return r; }
__device__ __forceinline__ float wave_sum(float v) {
#pragma unroll
    for (int o = 1; o < 64; o <<= 1) v += __shfl_xor(v, o);
    return v;
}

__device__ __forceinline__ void conv_item(const float* W, int ldw, int srccol0, int nvalid, const float* gain, bf16_t* dst, int K, int k0, float* scr, int lane) {
    const int c4 = (lane & 7) * 4, kr = lane >> 3;
    if (nvalid == 32 && ((ldw | srccol0) & 3) == 0) {
#pragma unroll
        for (int i = 0; i < 8; ++i) { const int kk = 8 * i + kr; f32x4 v = *(const f32x4*)(W + (size_t)(k0 + kk) * ldw + srccol0 + c4);
            if (gain) v = v * gain[k0 + kk];
            scr[kk * 33 + c4] = v[0]; scr[kk * 33 + c4 + 1] = v[1]; scr[kk * 33 + c4 + 2] = v[2]; scr[kk * 33 + c4 + 3] = v[3]; }
    } else {
#pragma unroll 8
        for (int i = 0; i < 32; ++i) { const int kk = 2 * i + (lane >> 5), c = lane & 31;
            float v = (c < nvalid) ? W[(size_t)(k0 + kk) * ldw + srccol0 + c] : 0.f;
            if (gain) v *= gain[k0 + kk];
            scr[kk * 33 + c] = v; }
    }
    __builtin_amdgcn_fence(__ATOMIC_RELEASE, "wavefront"); __builtin_amdgcn_wave_barrier();
    const int c8 = lane & 7;
#pragma unroll
    for (int j = 0; j < 4; ++j) { const int n = (lane >> 3) + 8 * j; const float* sp = scr + (8 * c8) * 33 + n;
        u32x4v o; o.x = cvtpk(sp[0 * 33], sp[1 * 33]); o.y = cvtpk(sp[2 * 33], sp[3 * 33]); o.z = cvtpk(sp[4 * 33], sp[5 * 33]); o.w = cvtpk(sp[6 * 33], sp[7 * 33]);
        *(u32x4v*)(dst + (size_t)n * K + k0 + 8 * c8) = o; }
    __builtin_amdgcn_fence(__ATOMIC_RELEASE, "wavefront"); __builtin_amdgcn_wave_barrier();
}
__device__ __forceinline__ int win_map(int n0) {
    if (n0 < 512) return 1024 + n0;
    if (n0 < 768) return 2048 + (n0 - 512);
    if (n0 < 1024) return 2816 + (n0 - 768);
    if (n0 < 2048) return n0 - 1024;
    if (n0 < 2560) return n0 - 512;
    if (n0 < 3072) return n0 - 256;
    return n0;
}
__device__ __forceinline__ void conv_one(const float* W, int K, int Nsrc, int srccol0, int ncols_src, const float* gain, bf16_t* dst, int Ndst, int map, int it, float* scr, int lane) {
    const int nblk = Ndst / 32; const int kb = it / nblk, nb = it % nblk, n0 = nb * 32;
    int sc, nv;
    if (map == 1) { sc = win_map(n0); nv = Nsrc - sc; } else if (map == 2) { const int tl = n0 >> 8, wi = n0 & 255; sc = wi < 128 ? tl * 128 + wi : FF + tl * 128 + (wi - 128); nv = 32; } else { sc = srccol0 + n0; nv = ncols_src - n0; }
    nv = nv < 0 ? 0 : (nv > 32 ? 32 : nv);
    conv_item(W, Nsrc, sc, nv, gain, dst + (size_t)n0 * K, K, kb * 64, scr, lane);
}
__device__ __forceinline__ void conv_mat(const float* W, int K, int Nsrc, int srccol0, int ncols_src, const float* gain, bf16_t* dst, int Ndst, int map, int gw, int NGW, float* scr, int lane) {
    const int nblk = Ndst / 32, nitems = (K / 64) * nblk;
    for (int it = gw; it < nitems; it += NGW) { const int kb = it / nblk, nb = it % nblk, n0 = nb * 32;
        int sc, nv;
        if (map == 1) { sc = win_map(n0); nv = Nsrc - sc; } else if (map == 2) { const int tl = n0 >> 8, wi = n0 & 255; sc = wi < 128 ? tl * 128 + wi : FF + tl * 128 + (wi - 128); nv = 32; } else { sc = srccol0 + n0; nv = ncols_src - n0; }
        nv = nv < 0 ? 0 : (nv > 32 ? 32 : nv);
        conv_item(W, Nsrc, sc, nv, gain, dst + (size_t)n0 * K, K, kb * 64, scr, lane); }
}
__device__ __forceinline__ void norm_rows(const float* X, bf16_t* XH, int nrows, int gw, int NGW, int lane) {
    for (int m = gw; m < nrows; m += NGW) { const f32x4* xr = (const f32x4*)(X + (size_t)m * DM) + lane;
        f32x4 v[4]; float s = 0.f;
#pragma unroll
        for (int j = 0; j < 4; ++j) { v[j] = xr[64 * j]; s += (v[j].x * v[j].x + v[j].y * v[j].y) + (v[j].z * v[j].z + v[j].w * v[j].w); }
        const float rstd = 1.0f / sqrtf(wave_sum(s) * (1.f / DM) + EPSN);
        u32x2v* o8 = (u32x2v*)(XH + (size_t)m * DM) + lane;
#pragma unroll
        for (int j = 0; j < 4; ++j) { u32x2v w; w.x = cvtpk(v[j].x * rstd, v[j].y * rstd); w.y = cvtpk(v[j].z * rstd, v[j].w * rstd); o8[64 * j] = w; } }
}
__device__ __forceinline__ void cast_rows(const float* X, bf16_t* XB, float* ssp, int nrows, int gw, int NGW, int lane) {
    for (int m = gw; m < nrows; m += NGW) { const f32x4* xr = (const f32x4*)(X + (size_t)m * DM) + lane;
        f32x4 v[4]; float s = 0.f;
#pragma unroll
        for (int j = 0; j < 4; ++j) { v[j] = xr[64 * j]; s += (v[j].x * v[j].x + v[j].y * v[j].y) + (v[j].z * v[j].z + v[j].w * v[j].w); }
        s = wave_sum(s);
        u32x2v* o8 = (u32x2v*)(XB + (size_t)m * DM) + lane;
#pragma unroll
        for (int j = 0; j < 4; ++j) { u32x2v w; w.x = cvtpk(v[j].x, v[j].y); w.y = cvtpk(v[j].z, v[j].w); o8[64 * j] = w; }
        if (lane < 16) ssp[(size_t)m * 16 + lane] = lane == 0 ? s : 0.f; }
}
__device__ __forceinline__ void final_rows(const bf16_t* XB, float* OUT, const float* g, int gw, int NGW, int lane) {
    const f32x4* gr = (const f32x4*)g + lane;
    for (int m = gw; m < MTOK; m += 2 * NGW) {
        const int m1 = m + NGW; const bool has1 = m1 < MTOK;
        const u32x2v* xr0 = (const u32x2v*)(XB + (size_t)m * DM) + lane; const u32x2v* xr1 = (const u32x2v*)(XB + (size_t)(has1 ? m1 : m) * DM) + lane;
        u32x2v w0[4], w1[4];
#pragma unroll
        for (int j = 0; j < 4; ++j) { w0[j] = xr0[64 * j]; w1[j] = xr1[64 * j]; }
        f32x4 v0[4], v1[4]; float s0 = 0.f, s1 = 0.f;
#pragma unroll
        for (int j = 0; j < 4; ++j) {
            v0[j][0] = __builtin_bit_cast(float, w0[j].x << 16); v0[j][1] = __builtin_bit_cast(float, w0[j].x & 0xffff0000u); v0[j][2] = __builtin_bit_cast(float, w0[j].y << 16); v0[j][3] = __builtin_bit_cast(float, w0[j].y & 0xffff0000u);
            v1[j][0] = __builtin_bit_cast(float, w1[j].x << 16); v1[j][1] = __builtin_bit_cast(float, w1[j].x & 0xffff0000u); v1[j][2] = __builtin_bit_cast(float, w1[j].y << 16); v1[j][3] = __builtin_bit_cast(float, w1[j].y & 0xffff0000u);
            s0 += (v0[j].x * v0[j].x + v0[j].y * v0[j].y) + (v0[j].z * v0[j].z + v0[j].w * v0[j].w); s1 += (v1[j].x * v1[j].x + v1[j].y * v1[j].y) + (v1[j].z * v1[j].z + v1[j].w * v1[j].w); }
#pragma unroll
        for (int o = 1; o < 64; o <<= 1) { s0 += __shfl_xor(s0, o); s1 += __shfl_xor(s1, o); }
        const float r0 = 1.0f / sqrtf(s0 * (1.f / DM) + EPSN), r1 = 1.0f / sqrtf(s1 * (1.f / DM) + EPSN);
        f32x4* o0 = (f32x4*)(OUT + (size_t)m * DM) + lane;
#pragma unroll
        for (int j = 0; j < 4; ++j) o0[64 * j] = v0[j] * r0 * gr[64 * j];
        if (has1) { f32x4* o1 = (f32x4*)(OUT + (size_t)m1 * DM) + lane;
#pragma unroll
            for (int j = 0; j < 4; ++j) o1[64 * j] = v1[j] * r1 * gr[64 * j]; }
    }
}
__device__ __forceinline__ float lam_init_of(int l) { return l == 0 ? 0.2f : (l == 1 ? 0.35550906759096926f : (l == 2 ? 0.47071301834358416f : 0.5560582041556405f)); }

constexpr int A_KOFF = 0, A_VOFF = 67584, A_TOFF = 102400, A_WOFF = 119808;
__device__ __forceinline__ int crowc(int r) { return (r & 3) + 8 * (r >> 2); }

template <int D, int DV, bool TAB, bool BITS, int KT>
__device__ __forceinline__ void attn_pass(unsigned char* lds, const bf16_t* Qp, int ldq, const bf16_t* Kp, int ldk, const bf16_t* Vtp, int ldvt,
                                          const float* tabg, const unsigned* bitsp, int q0, int t_lo, int t_hi, int win, float c2, f32x16 (&o)[DV / 32], bool ltab) {
    constexpr int KP = D * 2 + 16, VP = KT * 2 + 8, KBUF = KT * KP, VBUF = DV * VP, DC = D / 8, VC = KT / 8, NKC = KT * DC / 512, NVC = DV * VC / 512, NSUB = KT / 64, NBW = KT / 32;
    constexpr int KOFF = 0, VOFF = 2 * KBUF, TOFF = VOFF + 2 * VBUF, WOFF = TOFF + TABN * 4;
    static_assert(WOFF + 2048 <= LDS_BYTES - 64, "attention LDS map");
    int tid_o = threadIdx.x; asm volatile("" : "+v"(tid_o));
    const int tid = tid_o, lane = tid & 63, wid = __builtin_amdgcn_readfirstlane(tid >> 6), r32 = lane & 31, hi = lane >> 5;
    float* tabL = (float*)(lds + TOFF); float* wsf = (float*)(lds + WOFF) + wid * 64;
    if (TAB && ltab) { for (int i = tid; i < TABN / 4; i += 512) ((f32x4*)tabL)[i] = ((const f32x4*)tabg)[i]; }
    bf16x8 qf[D / 16];
    { const bf16_t* qrow = Qp + (size_t)(32 * wid + r32) * ldq + 8 * hi;
#pragma unroll
      for (int kk = 0; kk < D / 16; ++kk) { const u32x4v raw = *(const u32x4v*)(qrow + kk * 16); u32x4v sc4;
#pragma unroll
          for (int e = 0; e < 4; ++e) { const float lo = __builtin_bit_cast(float, raw[e] << 16) * c2, hh = __builtin_bit_cast(float, raw[e] & 0xffff0000u) * c2; sc4[e] = cvtpk(lo, hh); }
          qf[kk] = __builtin_bit_cast(bf16x8, sc4); } }
#pragma unroll
    for (int dt = 0; dt < DV / 32; ++dt)
#pragma unroll
        for (int r = 0; r < 16; ++r) o[dt][r] = 0.f;
    float mhat = 0.f, l_run = 0.f;
    const int qpos = q0 + 32 * wid + r32, qw_lo = q0 + 32 * wid, qw_hi = qw_lo + 31;
    u32x4v kreg[NKC], vreg[NVC];
#define AT_LOAD(t) do { const int k0_ = (t) * KT; \
        _Pragma("unroll") for (int i = 0; i < NKC; ++i) { const int c = tid + i * 512, key = c / DC, ch = c % DC; kreg[i] = *(const u32x4v*)(Kp + (size_t)(k0_ + key) * ldk + ch * 8); } \
        _Pragma("unroll") for (int i = 0; i < NVC; ++i) { const int c = tid + i * 512, row = c / VC, ch = c % VC; vreg[i] = *(const u32x4v*)(Vtp + (size_t)row * ldvt + k0_ + ch * 8); } } while (0)
#define AT_STORE(buf) do { \
        _Pragma("unroll") for (int i = 0; i < NKC; ++i) { const int c = tid + i * 512, key = c / DC, ch = c % DC; *(u32x4v*)(lds + KOFF + (buf) * KBUF + key * KP + ch * 16) = kreg[i]; } \
        _Pragma("unroll") for (int i = 0; i < NVC; ++i) { const int c = tid + i * 512, row = c / VC, ch = c % VC; unsigned char* d_ = lds + VOFF + (buf) * VBUF + row * VP + ch * 16; \
            *(u32x2v*)d_ = (u32x2v){vreg[i].x, vreg[i].y}; *(u32x2v*)(d_ + 8) = (u32x2v){vreg[i].z, vreg[i].w}; } } while (0)
    AT_LOAD(t_lo); AT_STORE(0);
    unsigned wq[NBW], wn[NBW];
    const unsigned* bprow = BITS ? bitsp + (size_t)(32 * wid + r32) * 128 : nullptr;
#pragma unroll
    for (int i = 0; i < NBW; ++i) { wq[i] = 0xffffffffu; wn[i] = 0xffffffffu; if (BITS) wq[i] = bprow[NBW * t_lo + i]; }
    __syncthreads();
    int cur = 0;
    for (int t = t_lo; t < t_hi; ++t) {
        if (t + 1 < t_hi) { AT_LOAD(t + 1); if (BITS) {
#pragma unroll
            for (int i = 0; i < NBW; ++i) wn[i] = bprow[NBW * (t + 1) + i]; } }
#pragma unroll
        for (int sub = 0; sub < NSUB; ++sub) {
        const int k0 = t * KT + sub * 64;
        bool active = true;
        if (TAB) active = (k0 <= qw_hi) && (k0 + 63 >= qw_lo - win);
        if (active) {
            const unsigned char* Kl = lds + KOFF + cur * KBUF + sub * 64 * KP; const unsigned char* Vl = lds + VOFF + cur * VBUF + sub * 128;
            f32x16 p0, p1;
            unsigned w0 = 0xffffffffu, w1 = 0xffffffffu;
            if (BITS) { w0 = wq[2 * sub] >> (4 * hi); w1 = wq[2 * sub + 1] >> (4 * hi); }
            const float nm = -mhat;
            const int tj = TABN - 1 - TABOFF - qpos + k0 + 4 * hi;
            constexpr int KG = (D > 64) ? 2 : 4;
            if (D == 64) {
                bf16x8 ka[4], kb[4];
                if (TAB) {
#pragma unroll
                    for (int r = 0; r < 16; ++r) p0[r] = tabL[tj + crowc(r)]; }
#pragma unroll
                for (int kk = 0; kk < 4; ++kk) ka[kk] = *(const bf16x8*)(Kl + r32 * KP + (kk * 16 + 8 * hi) * 2);
                if (TAB) {
#pragma unroll
                    for (int r = 0; r < 16; ++r) p1[r] = tabL[tj + 32 + crowc(r)]; }
#pragma unroll
                for (int kk = 0; kk < 4; ++kk) kb[kk] = *(const bf16x8*)(Kl + (32 + r32) * KP + (kk * 16 + 8 * hi) * 2);
                __builtin_amdgcn_sched_barrier(0);
#pragma unroll
                for (int r = 0; r < 16; ++r) { if (TAB) p0[r] -= mhat; else p0[r] = nm; if (BITS) { if (!((w0 >> crowc(r)) & 1u)) p0[r] = NEGV; } }
                __builtin_amdgcn_sched_barrier(0);
#pragma unroll
                for (int kk = 0; kk < 4; ++kk) p0 = __builtin_amdgcn_mfma_f32_32x32x16_bf16(ka[kk], qf[kk], p0, 0, 0, 0);
#pragma unroll
                for (int r = 0; r < 16; ++r) { if (TAB) p1[r] -= mhat; else p1[r] = nm; if (BITS) { if (!((w1 >> crowc(r)) & 1u)) p1[r] = NEGV; } }
                __builtin_amdgcn_sched_barrier(0);
#pragma unroll
                for (int kk = 0; kk < 4; ++kk) p1 = __builtin_amdgcn_mfma_f32_32x32x16_bf16(kb[kk], qf[kk], p1, 0, 0, 0);
                __builtin_amdgcn_sched_barrier(0);
            } else {
                if (TAB) {
#pragma unroll
                    for (int r = 0; r < 16; ++r) p0[r] = tabL[tj + crowc(r)];
#pragma unroll
                    for (int r = 0; r < 16; ++r) p1[r] = tabL[tj + 32 + crowc(r)];
                    __builtin_amdgcn_sched_barrier(0);
#pragma unroll
                    for (int r = 0; r < 16; ++r) { p0[r] -= mhat; p1[r] -= mhat; }
                } else {
#pragma unroll
                    for (int r = 0; r < 16; ++r) { p0[r] = nm; p1[r] = nm; }
                }
                if (BITS) {
#pragma unroll
                    for (int r = 0; r < 16; ++r) { const int off = crowc(r); if (!((w0 >> off) & 1u)) p0[r] = NEGV; if (!((w1 >> off) & 1u)) p1[r] = NEGV; } }
#pragma unroll
                for (int k4 = 0; k4 < D / 16; k4 += KG) {
                    bf16x8 ka[KG], kb[KG];
#pragma unroll
                    for (int kk = 0; kk < KG; ++kk) { ka[kk] = *(const bf16x8*)(Kl + r32 * KP + ((k4 + kk) * 16 + 8 * hi) * 2); kb[kk] = *(const bf16x8*)(Kl + (32 + r32) * KP + ((k4 + kk) * 16 + 8 * hi) * 2); }
                    __builtin_amdgcn_sched_barrier(0);
#pragma unroll
                    for (int kk = 0; kk < KG; ++kk) { p0 = __builtin_amdgcn_mfma_f32_32x32x16_bf16(ka[kk], qf[k4 + kk], p0, 0, 0, 0); p1 = __builtin_amdgcn_mfma_f32_32x32x16_bf16(kb[kk], qf[k4 + kk], p1, 0, 0, 0); }
                    __builtin_amdgcn_sched_barrier(0);
                }
            }
            asm volatile("s_nop 15\n\ts_nop 7" : "+v"(p0), "+v"(p1));
            float mx = max3f(p0[0], p1[0], p0[1]), mx2 = max3f(p1[1], p0[2], p1[2]);
#pragma unroll
            for (int r = 3; r < 15; r += 2) { mx = max3f(mx, p0[r], p1[r]); mx2 = max3f(mx2, p0[r + 1], p1[r + 1]); }
            mx = max3f(mx, p0[15], p1[15]); mx = max3f(mx, mx2, mx2);
            mx = swap32_max(mx);
            if (__any(mx > 8.0f)) {
                const float dl = fmaxf(mx, 0.f); mhat += dl;
#pragma unroll
                for (int r = 0; r < 16; ++r) { p0[r] -= dl; p1[r] -= dl; }
                const float alpha = __builtin_amdgcn_exp2f(-dl); l_run *= alpha;
                if (hi == 0) wsf[r32] = alpha;
                __builtin_amdgcn_fence(__ATOMIC_RELEASE, "wavefront"); __builtin_amdgcn_wave_barrier();
#pragma unroll
                for (int j = 0; j < 4; ++j) { const f32x4 a4 = *(const f32x4*)(wsf + 8 * j + 4 * hi);
#pragma unroll
                    for (int dt = 0; dt < DV / 32; ++dt) { o[dt][4 * j + 0] *= a4[0]; o[dt][4 * j + 1] *= a4[1]; o[dt][4 * j + 2] *= a4[2]; o[dt][4 * j + 3] *= a4[3]; } }
                __builtin_amdgcn_fence(__ATOMIC_RELEASE, "wavefront"); __builtin_amdgcn_wave_barrier();
            }
            float rs = 0.f;
            bf16x8 vc[DV / 32];
#define AT_VLOAD(dst, g) do { _Pragma("unroll") for (int dt = 0; dt < DV / 32; ++dt) { const unsigned char* vp = Vl + (dt * 32 + r32) * VP + (16 * (g) + 4 * hi) * 2; \
                const s16x4 lo = *(const s16x4*)vp, hh = *(const s16x4*)(vp + 16); dst[dt] = (bf16x8){lo[0], lo[1], lo[2], lo[3], hh[0], hh[1], hh[2], hh[3]}; } } while (0)
#pragma unroll
            for (int g = 0; g < 4; ++g) {
                AT_VLOAD(vc, g);
                float e[8];
#pragma unroll
                for (int i = 0; i < 8; ++i) { e[i] = __builtin_amdgcn_exp2f(g < 2 ? p0[(g & 1) * 8 + i] : p1[(g & 1) * 8 + i]); rs += e[i]; }
                u32x4v pw; pw.x = cvtpk(e[0], e[1]); pw.y = cvtpk(e[2], e[3]); pw.z = cvtpk(e[4], e[5]); pw.w = cvtpk(e[6], e[7]);
                const bf16x8 pa = __builtin_bit_cast(bf16x8, pw);
                __builtin_amdgcn_sched_barrier(0x1 | 0x2 | 0x100);
#pragma unroll
                for (int dt = 0; dt < DV / 32; ++dt) o[dt] = __builtin_amdgcn_mfma_f32_32x32x16_bf16(pa, vc[dt], o[dt], 0, 0, 0);
                __builtin_amdgcn_sched_barrier(0x1 | 0x2 | 0x100);
            }
            l_run += rs;
#undef AT_VLOAD
        }
        }
        if (t + 1 < t_hi) AT_STORE(cur ^ 1);
        if (BITS) {
#pragma unroll
            for (int i = 0; i < NBW; ++i) wq[i] = wn[i]; }
        __syncthreads();
        cur ^= 1;
    }
#undef AT_LOAD
#undef AT_STORE
    const float lt = swap32_add(l_run);
    if (hi == 0) wsf[r32] = 1.0f / fmaxf(lt, 1e-30f);
    __builtin_amdgcn_fence(__ATOMIC_RELEASE, "wavefront"); __builtin_amdgcn_wave_barrier();
#pragma unroll
    for (int j = 0; j < 4; ++j) { const f32x4 a4 = *(const f32x4*)(wsf + 8 * j + 4 * hi);
#pragma unroll
        for (int dt = 0; dt < DV / 32; ++dt) { o[dt][4 * j + 0] *= a4[0]; o[dt][4 * j + 1] *= a4[1]; o[dt][4 * j + 2] *= a4[2]; o[dt][4 * j + 3] *= a4[3]; } }
    __builtin_amdgcn_fence(__ATOMIC_RELEASE, "wavefront"); __builtin_amdgcn_wave_barrier();
}
template <int DV>
__device__ __forceinline__ void attn_store(const f32x16 (&o)[DV / 32], bf16_t* Op, int ldo) {
    int tid_o = threadIdx.x; asm volatile("" : "+v"(tid_o));
    const int lane = tid_o & 63, wid = tid_o >> 6, r32 = lane & 31, hi = lane >> 5;
#pragma unroll
    for (int dt = 0; dt < DV / 32; ++dt)
#pragma unroll
        for (int r = 0; r < 16; ++r) { const int row = 32 * wid + crowc(r) + 4 * hi; Op[(size_t)row * ldo + dt * 32 + r32] = (bf16_t)(cvtpk(o[dt][r], 0.f) & 0xffffu); }
}
__device__ __forceinline__ void deal_unit(int it, int& b, int& h, int& qb) { const int bh = it & 63, qs = it >> 6, i = qs >> 2, s = qs & 3; b = bh >> 2; h = bh & 3; qb = (i & 1) ? (4 * i + 3 - s) : (4 * i + s); }

__device__ __forceinline__ void pk_cnt_lt(unsigned& acc, unsigned k2, unsigned mid2, unsigned one2) {
    unsigned t; asm volatile("v_pk_sub_u16 %0, %2, %3 clamp\n\tv_pk_min_u16 %0, %0, %4\n\tv_pk_add_u16 %1, %1, %0" : "=&v"(t), "+v"(acc) : "v"(mid2), "v"(k2), "v"(one2));
}
__device__ __forceinline__ int red32(int v) {
    v += __builtin_amdgcn_mov_dpp(v, 0xB1, 0xf, 0xf, true);
    v += __builtin_amdgcn_mov_dpp(v, 0x4E, 0xf, 0xf, true);
    v += __builtin_amdgcn_mov_dpp(v, 0x141, 0xf, 0xf, true);
    v += __builtin_amdgcn_mov_dpp(v, 0x140, 0xf, 0xf, true);
    v += __builtin_amdgcn_ds_swizzle(v, 0x401F);
    return v;
}
__device__ __forceinline__ unsigned ltu(unsigned a, unsigned b) { unsigned d; asm volatile("v_sub_u32 %0, %1, %2\n\tv_lshrrev_b32 %0, 31, %0" : "=v"(d) : "v"(a), "v"(b)); return d; }
__device__ __forceinline__ unsigned pk_flag_gt(unsigned k2, unsigned T2, unsigned one2) { unsigned t; asm volatile("v_pk_sub_u16 %0, %1, %2 clamp\n\tv_pk_min_u16 %0, %0, %3" : "=&v"(t) : "v"(k2), "v"(T2), "v"(one2)); return t; }
__device__ __forceinline__ int scan32_incl(int x, int lane) {
    x += __builtin_amdgcn_update_dpp(0, x, 0x111, 0xf, 0xf, true);
    x += __builtin_amdgcn_update_dpp(0, x, 0x112, 0xf, 0xf, true);
    x += __builtin_amdgcn_update_dpp(0, x, 0x114, 0xf, 0xf, true);
    x += __builtin_amdgcn_update_dpp(0, x, 0x118, 0xf, 0xf, true);
    const int r15 = __builtin_amdgcn_readlane(x, 15), r47 = __builtin_amdgcn_readlane(x, 47);
    x += (lane & 16) ? ((lane & 32) ? r47 : r15) : 0;
    return x;
}
template <int NCH>
__device__ __forceinline__ void idx_select(const unsigned short* sc, unsigned* bits, size_t tok0, int tid) {
    const int row = tid >> 5, j = tid & 31, lane = tid & 63;
    unsigned kw[4 * NCH];
    { const u32x4v* src = (const u32x4v*)(sc + row * 4096) + j;
#pragma unroll
      for (int i = 0; i < NCH; ++i) { const u32x4v v = src[i * 32]; kw[4 * i] = v.x; kw[4 * i + 1] = v.y; kw[4 * i + 2] = v.z; kw[4 * i + 3] = v.w; } }
    const unsigned one2 = 0x00010001u;
    unsigned lo = 1u, hi_ = 0xFFFFu;
#pragma unroll 1
    for (int it = 0; it < 16; ++it) { const unsigned mid = (lo + hi_ + 1u) >> 1, mid2 = mid | (mid << 16);
        unsigned c2a = 0u, c2b = 0u;
#pragma unroll
        for (int i = 0; i < 4 * NCH; i += 2) { pk_cnt_lt(c2a, kw[i], mid2, one2); pk_cnt_lt(c2b, kw[i + 1], mid2, one2); }
        int cnt = 8 * NCH - (int)((c2a & 0xFFFFu) + (c2a >> 16) + (c2b & 0xFFFFu) + (c2b >> 16));
        cnt = red32(cnt);
        if (cnt >= 256) lo = mid; else hi_ = mid - 1u;
        if (cnt == 256) hi_ = mid;
        if (__all(lo == hi_)) break; }
    const unsigned T = lo, T2 = T | (T << 16);
    unsigned gm[NCH], em[NCH]; int cgt = 0;
#pragma unroll
    for (int i = 0; i < NCH; ++i) { unsigned g8 = 0u, e8 = 0u;
#pragma unroll
        for (int w = 0; w < 4; ++w) { const unsigned g2 = pk_flag_gt(kw[4 * i + w], T2, one2), l2 = pk_flag_gt(T2, kw[4 * i + w], one2), e2 = one2 - g2 - l2;
            g8 |= ((g2 | (g2 >> 15)) & 3u) << (2 * w); e8 |= ((e2 | (e2 >> 15)) & 3u) << (2 * w); }
        gm[i] = g8; em[i] = e8; cgt += __builtin_popcount(g8); }
    const int need = 256 - red32(cgt);
    int carry = 0;
    unsigned char* brow = (unsigned char*)(bits + (tok0 + row) * 128);
#pragma unroll
    for (int i = 0; i < NCH; ++i) { const int ec = __builtin_popcount(em[i]); const int incl = scan32_incl(ec, lane);
        const int quota = need - carry - (incl - ec);
        unsigned se = (quota >= ec) ? em[i] : 0u;
        if (__any(quota > 0 && quota < ec)) { unsigned m = em[i], r = 0u;
#pragma unroll
            for (int t = 0; t < 8; ++t) { const unsigned b = m & (0u - m); if (t < quota) r |= b; m ^= b; }
            if (quota > 0 && quota < ec) se = r; }
        carry += (lane & 32) ? __builtin_amdgcn_readlane(incl, 63) : __builtin_amdgcn_readlane(incl, 31);
        brow[i * 32 + j] = (unsigned char)(gm[i] | se); }
    if (NCH < 16) { unsigned* zr = (unsigned*)(brow + NCH * 32);
#pragma unroll
        for (int i = 0; i < (16 - NCH) * 8; i += 32) if (i + j < (16 - NCH) * 8) zr[i + j] = 0u; }
}

__device__ __forceinline__ void idx_unit(unsigned char* lds, const bf16_t* P, int b, int qb16, unsigned* bits) {
    int tid_o = threadIdx.x; asm volatile("" : "+v"(tid_o));
    const int tid = tid_o, lane = tid & 63, wid = __builtin_amdgcn_readfirstlane(tid >> 6), r32 = lane & 31, hi = lane >> 5;
    unsigned short* sc = (unsigned short*)lds;
    float* wl = (float*)(lds + 131072);
    const int t0 = qb16 * 16; const size_t tokb = (size_t)b * SEQ, tok0 = tokb + t0;
    const int nscan = ((t0 + 16 + 511) >> 9) << 9;
    const int ncomp = ((t0 + 16 + 31) / 32);
    const int nblk = ncomp;
    if (tid < 128) wl[tid] = bf2f(P[(tok0 + (tid >> 3)) * PW + P_IW + (tid & 7)]) * (0.35355339059327373f * 0.125f);
    bf16x8 aq[4][4];
#pragma unroll
    for (int rb = 0; rb < 4; ++rb) { const bf16_t* ap = P + (tok0 + rb * 4 + (r32 >> 3)) * PW + P_IQ + (r32 & 7) * 64 + 8 * hi;
#pragma unroll
        for (int kk = 0; kk < 4; ++kk) aq[rb][kk] = *(const bf16x8*)(ap + kk * 16); }
    __syncthreads();
    f32x4 wreg[16];
#pragma unroll
    for (int q = 0; q < 16; ++q) wreg[q] = *(const f32x4*)(wl + q * 8 + 4 * hi);
    bf16x8 bk[4], bn[4];
    { const bf16_t* kp = P + (tokb + (wid < nblk ? wid : 0) * 32 + r32) * PW + P_IK + 8 * hi;
#pragma unroll
      for (int kk = 0; kk < 4; ++kk) { bk[kk] = *(const bf16x8*)(kp + kk * 16); bn[kk] = bk[kk]; } }
    for (int blk = wid; blk < nblk; blk += 8) {
        const int key = blk * 32 + r32;
        if (blk + 8 < nblk) { const bf16_t* kp = P + (tokb + key + 256) * PW + P_IK + 8 * hi;
#pragma unroll
            for (int kk = 0; kk < 4; ++kk) bn[kk] = *(const bf16x8*)(kp + kk * 16); }
#pragma unroll
        for (int rb = 0; rb < 4; ++rb) {
            f32x16 c;
#pragma unroll
            for (int r = 0; r < 16; ++r) c[r] = 0.f;
#pragma unroll
            for (int kk = 0; kk < 4; ++kk) c = __builtin_amdgcn_mfma_f32_32x32x16_bf16(aq[rb][kk], bk[kk], c, 0, 0, 0);
            asm volatile("s_nop 15\n\ts_nop 7" : "+v"(c));
            float tq0, tq1, tq2, tq3;
#define IDX_TOT(j) ({ const f32x4 w4 = wreg[rb * 4 + (j)]; \
                const float part = w4[0] * reluf(c[4 * (j)]) + w4[1] * reluf(c[4 * (j) + 1]) + w4[2] * reluf(c[4 * (j) + 2]) + w4[3] * reluf(c[4 * (j) + 3]); swap32_add(part); })
            tq0 = IDX_TOT(0); tq1 = IDX_TOT(1); tq2 = IDX_TOT(2); tq3 = IDX_TOT(3);
#undef IDX_TOT
            const float ts0 = hi ? tq2 : tq0, ts1 = hi ? tq3 : tq1;
#pragma unroll
            for (int jj = 0; jj < 2; ++jj) { const float tv = jj ? ts1 : ts0; const int q = rb * 4 + 2 * hi + jj;
                unsigned short kv = 0;
                if (key <= t0 + q) { const _Float16 hv = (_Float16)tv; const unsigned short hb = __builtin_bit_cast(unsigned short, hv); kv = (hb & 0x8000u) ? (unsigned short)~hb : (unsigned short)(hb | 0x8000u); }
                sc[q * 4096 + key] = kv; }
        }
#pragma unroll
        for (int kk = 0; kk < 4; ++kk) bk[kk] = bn[kk];
    }
    { const int z0 = ncomp * 32, zn = (nscan - z0) >> 3;
      for (int e = tid; e < zn * 16; e += 512) { const int r = e / zn, c = e - r * zn; *(u32x4v*)(sc + r * 4096 + z0 + 8 * c) = (u32x4v){0u, 0u, 0u, 0u}; } }
    __syncthreads();
    switch (nscan >> 9) {
        case 1: idx_select<2>(sc, bits, tok0, tid); break;
        case 2: idx_select<4>(sc, bits, tok0, tid); break;
        case 3: idx_select<6>(sc, bits, tok0, tid); break;
        case 4: idx_select<8>(sc, bits, tok0, tid); break;
        case 5: idx_select<10>(sc, bits, tok0, tid); break;
        case 6: idx_select<12>(sc, bits, tok0, tid); break;
        case 7: idx_select<14>(sc, bits, tok0, tid); break;
        default: idx_select<16>(sc, bits, tok0, tid); break;
    }
    __syncthreads();
}

struct MixCtx { const bf16_t* P; const bf16_t* VT; bf16_t* MIX; const float* tabs; const unsigned* bits; const float* subln_base; const float* lamv; int l; float* stash; int nthr; };

__device__ __forceinline__ void unitA(unsigned char* lds, const MixCtx& c, int b, int h, int qb, bool ltab) {
    const int q0 = qb * 256; const size_t tokb = (size_t)b * SEQ; const int t_hi = (q0 + 256) / 128;
    const float c2 = 0.125f * LOG2E;
    f32x16 oa[4], ob[4];
    attn_pass<64, 128, true, false, 128>(lds, c.P + (tokb + q0) * PW + P_AQ + h * 128, PW, c.P + tokb * PW + P_AK + h * 128, PW, c.VT + (size_t)(V_A + h * 128) * MTOK + tokb, MTOK,
                                    c.tabs + h * TABN, nullptr, q0, 0, t_hi, 1 << 24, c2, oa, ltab);
    { int tid_s = threadIdx.x; asm volatile("" : "+v"(tid_s)); float* st = c.stash + (size_t)blockIdx.x * 512 + tid_s; asm volatile("" : "+v"(st));
#pragma unroll
      for (int dt = 0; dt < 4; ++dt)
#pragma unroll
          for (int r = 0; r < 16; ++r) st[(size_t)(dt * 16 + r) * c.nthr] = oa[dt][r];
      asm volatile("" ::: "memory"); }
    attn_pass<64, 128, true, false, 128>(lds, c.P + (tokb + q0) * PW + P_AQ + h * 128 + 64, PW, c.P + tokb * PW + P_AK + h * 128 + 64, PW, c.VT + (size_t)(V_A + h * 128) * MTOK + tokb, MTOK,
                                    c.tabs + h * TABN, nullptr, q0, 0, t_hi, 1 << 24, c2, ob, false);
    int l_o = c.l; asm volatile("" : "+s"(l_o));
    const float lam = c.lamv[l_o], lam_init = lam_init_of(l_o); const float* subln = c.subln_base + l_o * 128;
    int tid_o = threadIdx.x; asm volatile("" : "+v"(tid_o));
    const int lane = tid_o & 63, r32 = lane & 31;
    { const float* st = c.stash + (size_t)blockIdx.x * 512 + tid_o; asm volatile("" : "+v"(st) :: "memory");
#pragma unroll
      for (int dt = 0; dt < 4; ++dt)
#pragma unroll
          for (int r = 0; r < 16; ++r) oa[dt][r] = st[(size_t)(dt * 16 + r) * c.nthr]; }
    float ss[16];
#pragma unroll
    for (int r = 0; r < 16; ++r) { float s = 0.f;
#pragma unroll
        for (int dt = 0; dt < 4; ++dt) { const float v = oa[dt][r] - lam * ob[dt][r]; oa[dt][r] = v; s += v * v; }
        ss[r] = s; }
#pragma unroll
    for (int r = 0; r < 16; ++r) {
#pragma unroll
        for (int o = 1; o < 32; o <<= 1) ss[r] += __shfl_xor(ss[r], o);
        ss[r] = (1.0f - lam_init) / sqrtf(ss[r] * (1.f / 128.f) + EPSN); }
#pragma unroll
    for (int dt = 0; dt < 4; ++dt) { const float g = subln[dt * 32 + r32];
#pragma unroll
        for (int r = 0; r < 16; ++r) oa[dt][r] = oa[dt][r] * ss[r] * g; }
    attn_store<128>(oa, c.MIX + (tokb + q0) * DM + h * 128, DM);
}
__device__ __forceinline__ void unitB(unsigned char* lds, const MixCtx& c, int b, int h, int qb, bool ltab) {
    const int q0 = qb * 256; const size_t tokb = (size_t)b * SEQ; const int t_hi = (q0 + 256) / 128; int t_lo = (q0 - 2048) / 128; if (t_lo < 0) t_lo = 0;
    f32x16 o[2];
    attn_pass<64, 64, true, false, 128>(lds, c.P + (tokb + q0) * PW + P_BQ + h * 64, PW, c.P + tokb * PW + P_BK + h * 64, PW, c.VT + (size_t)(V_B + h * 64) * MTOK + tokb, MTOK,
                                   c.tabs + (4 + h) * TABN, nullptr, q0, t_lo, t_hi, 2048, 0.125f * LOG2E, o, ltab);
    attn_store<64>(o, c.MIX + (tokb + q0) * DM + 512 + h * 64, DM);
}
__device__ __forceinline__ void unitC(unsigned char* lds, const MixCtx& c, int b, int h, int qb, bool ltab) {
    const int q0 = qb * 256; const size_t tokb = (size_t)b * SEQ; const int t_hi = (q0 + 256) / 128;
    f32x16 o[2];
    attn_pass<64, 64, true, true, 128>(lds, c.P + (tokb + q0) * PW + P_CQ + h * 64, PW, c.P + tokb * PW + P_CK + h * 64, PW, c.VT + (size_t)(V_C + h * 64) * MTOK + tokb, MTOK,
                                  c.tabs + (8 + h) * TABN, c.bits + (tokb + q0) * 128, q0, 0, t_hi, 1 << 24, 0.125f * LOG2E, o, ltab);
    attn_store<64>(o, c.MIX + (tokb + q0) * DM + 768 + h * 64, DM);
}
__device__ __forceinline__ void unitM(unsigned char* lds, const bf16_t* QM, const bf16_t* MK, const bf16_t* MVT, bf16_t* MIX, int l, int b, int h, int half, int qb) {
    const int q0 = qb * 256; const size_t tokb = (size_t)b * SEQ;
    f32x16 o[4];
    attn_pass<256, 128, false, false, 64>(lds, QM + (tokb + q0) * DM + h * 256, DM, MK + (size_t)(b * MEMLEN) * 4096 + l * 1024 + h * 256, 4096,
                                      MVT + (size_t)(l * 1024 + h * 256 + half * 128) * MMEM + b * MEMLEN, MMEM, nullptr, nullptr, q0, 0, MEMLEN / 64, 1 << 24, 0.0625f * LOG2E, o, false);
    attn_store<128>(o, MIX + (tokb + q0) * DM + h * 256 + half * 128, DM);
}

__device__ __forceinline__ void conv_fix_phase(const bf16_t* Fb, const bf16_t* Hb, bf16_t* G, const float* cw, const float* cb, int gtid, int nthr) {
    constexpr int CG = FF / 8, NSEG = MTOK / 64;
    const int nitems = NSEG * 2 * CG;
    for (int it = gtid; it < nitems; it += nthr) { const int cgi = it % CG, rest = it / CG, i = rest & 1, sg = rest >> 1, c0 = cgi * 8;
        const bool has = ((sg * 64) & (SEQ - 1)) != 0;
        const u32x4v z = (u32x4v){0u, 0u, 0u, 0u};
        const u32x4v u0g = *(const u32x4v*)(Fb + ((size_t)sg * 2 + i) * FF2 + c0), u0v = *(const u32x4v*)(Fb + ((size_t)sg * 2 + i) * FF2 + FF + c0);
        u32x4v p1g = z, p1v = z, p2g = z, p2v = z;
        if (i == 0) { if (has) { p1g = *(const u32x4v*)(Hb + ((size_t)(sg - 1) * 2 + 1) * FF2 + c0); p1v = *(const u32x4v*)(Hb + ((size_t)(sg - 1) * 2 + 1) * FF2 + FF + c0);
                                 p2g = *(const u32x4v*)(Hb + ((size_t)(sg - 1) * 2) * FF2 + c0); p2v = *(const u32x4v*)(Hb + ((size_t)(sg - 1) * 2) * FF2 + FF + c0); } }
        else { p1g = *(const u32x4v*)(Fb + ((size_t)sg * 2) * FF2 + c0); p1v = *(const u32x4v*)(Fb + ((size_t)sg * 2) * FF2 + FF + c0);
               if (has) { p2g = *(const u32x4v*)(Hb + ((size_t)(sg - 1) * 2 + 1) * FF2 + c0); p2v = *(const u32x4v*)(Hb + ((size_t)(sg - 1) * 2 + 1) * FF2 + FF + c0); } }
        float og[8];
#pragma unroll
        for (int e = 0; e < 8; ++e) { const int w = e >> 1, sh = (e & 1) * 16;
            const float a2 = __builtin_bit_cast(float, ((p2g[w] >> sh) & 0xffffu) << 16), a1 = __builtin_bit_cast(float, ((p1g[w] >> sh) & 0xffffu) << 16), a0 = __builtin_bit_cast(float, ((u0g[w] >> sh) & 0xffffu) << 16);
            const float b2 = __builtin_bit_cast(float, ((p2v[w] >> sh) & 0xffffu) << 16), b1 = __builtin_bit_cast(float, ((p1v[w] >> sh) & 0xffffu) << 16), b0 = __builtin_bit_cast(float, ((u0v[w] >> sh) & 0xffffu) << 16);
            const float cgate = cb[c0 + e] + cw[c0 + e] * a2 + cw[FF2 + c0 + e] * a1 + cw[2 * FF2 + c0 + e] * a0;
            const float cval = cb[FF + c0 + e] + cw[FF + c0 + e] * b2 + cw[FF2 + FF + c0 + e] * b1 + cw[2 * FF2 + FF + c0 + e] * b0;
            og[e] = cgate / (1.0f + __expf(-cgate)) * cval; }
        u32x4v w; w.x = cvtpk(og[0], og[1]); w.y = cvtpk(og[2], og[3]); w.z = cvtpk(og[4], og[5]); w.w = cvtpk(og[6], og[7]);
        *(u32x4v*)(G + ((size_t)sg * 64 + i) * FF + c0) = w; }
}

#define RLX_AGENT __ATOMIC_RELAXED, __HIP_MEMORY_SCOPE_AGENT
struct XcdBarrier { unsigned* bar; unsigned x; volatile LAS unsigned* st; };
#define XB_TMO      128
#define XB_XCNT(j)  (256  + 64 * (j))
#define XB_XSUB(j)  (1280 + 64 * (j))
#define XB_XGEN(j)  (2304 + 64 * (j))
#define XB_TOP      3328
#define XB_TOPGEN   3392
#define XCD_BAR_WORDS 3456
#define XB_SPIN_CAP (1u << 18)

__device__ __forceinline__ unsigned xb_ld(unsigned* p)              { return __hip_atomic_load(p, __ATOMIC_RELAXED, __HIP_MEMORY_SCOPE_AGENT); }
__device__ __forceinline__ unsigned xb_add(unsigned* p, unsigned v) { return __hip_atomic_fetch_add(p, v, __ATOMIC_RELAXED, __HIP_MEMORY_SCOPE_AGENT); }
__device__ __forceinline__ unsigned xb_xcc_id() { return (unsigned)__builtin_amdgcn_s_getreg((3 << 11) | 20) & 0xFu; }
#define XB_SPIN(cond, bar) do { unsigned _sp = 0; while (cond) { __builtin_amdgcn_s_sleep(1); \
    if ((++_sp & 255u) == 0u) { if (xb_ld(&(bar)[XB_TMO])) break; if (_sp > XB_SPIN_CAP) { atomicAdd(&(bar)[XB_TMO], 1u); break; } } } } while (0)

__device__ __forceinline__ XcdBarrier xcd_barrier_post(unsigned* bar, volatile LAS unsigned* st) {
    XcdBarrier b; b.bar = bar; b.x = xb_xcc_id(); b.st = st;
    if (threadIdx.x == 0) (void)xb_add(&bar[XB_XCNT(b.x)], 1u);
    return b;
}
__device__ __forceinline__ void xcd_barrier_complete(unsigned* bar, unsigned x, unsigned& nloc, unsigned& nx) {
    const unsigned G = gridDim.x * gridDim.y * gridDim.z;
    unsigned sum, cnt, mine, sp = 0u;
    for (;;) {
        sum = 0u; cnt = 0u; mine = 0u;
#pragma unroll
        for (unsigned j = 0; j < 16; ++j) { const unsigned c = xb_ld(&bar[XB_XCNT(j)]); sum += c; cnt += (c > 0u) ? 1u : 0u; mine = (j == x) ? c : mine; }
        if (sum == G) break;
        __builtin_amdgcn_s_sleep(1);
        if ((++sp & 255u) == 0u) { if (xb_ld(&bar[XB_TMO])) break; if (sp > XB_SPIN_CAP) { atomicAdd(&bar[XB_TMO], 1u); break; } }
    }
    nloc = mine > 0u ? mine : 1u; nx = cnt > 0u ? cnt : 1u;
}

__device__ __forceinline__ void xcd_barrier(const XcdBarrier& b) {
    asm volatile("s_waitcnt vmcnt(0)" ::: "memory");
    __syncthreads();
    if (threadIdx.x == 0) {
        unsigned* bar = b.bar;
        __builtin_amdgcn_s_waitcnt(0);
        unsigned nloc = b.st[0], nx = b.st[1];
        if (nloc == 0u) { xcd_barrier_complete(bar, b.x, nloc, nx); b.st[0] = nloc; b.st[1] = nx; }
        const unsigned old = xb_add(&bar[XB_XSUB(b.x)], 1u);
        const unsigned gen = old / nloc;
        if (old + 1u == (gen + 1u) * nloc) {
            __builtin_amdgcn_fence(__ATOMIC_RELEASE, "agent");
            asm volatile("s_waitcnt vmcnt(0)" ::: "memory");
            const unsigned og = xb_add(&bar[XB_TOP], 1u);
            const unsigned tg = og / nx;
            if (og + 1u == (tg + 1u) * nx) xb_add(&bar[XB_TOPGEN], 1u);
            else XB_SPIN(xb_ld(&bar[XB_TOPGEN]) == tg, bar);
            __builtin_amdgcn_fence(__ATOMIC_ACQUIRE, "agent");
            xb_add(&bar[XB_XGEN(b.x)], 1u);
            asm volatile("s_waitcnt vmcnt(0)" ::: "memory");
        } else {
            XB_SPIN(xb_ld(&bar[XB_XGEN(b.x)]) == gen, bar);
            __builtin_amdgcn_fence(__ATOMIC_ACQUIRE, "agent");
            asm volatile("s_waitcnt vmcnt(0)" ::: "memory");
        }
    }
    __syncthreads();
}

template <class Epi>
__device__ __forceinline__ void run_gemm(LAS unsigned char* ldsl, const bf16_t* A, const bf16_t* Bt, int M, int N, int K, const Epi& E) {
    pg8::Gemm g{A, Bt, M, N, K}; pg8::StaticOrder S; S.init(M, N, (int)gridDim.x, (int)blockIdx.x);
    pg8::gemm_phase<Epi, pg8::StaticOrder, true, true>(ldsl, g, S, E);
}

struct Args { const float* in[22]; float* out; unsigned char* ws; };

__global__ void __launch_bounds__(512, 2) fwd_kernel(Args a) {
    extern __shared__ __attribute__((aligned(16))) unsigned char lds[];
    cg::grid_group grid = cg::this_grid();
    LAS unsigned char* ldsl = (LAS unsigned char*)lds;
    const int G = gridDim.x, cb_ = blockIdx.x, NGW = G * 8, NTHR = G * 512;
    { volatile LAS unsigned* stw = (volatile LAS unsigned*)(ldsl + LDS_BYTES - 64); if (threadIdx.x < 16) stw[threadIdx.x] = 0u; }
    __syncthreads();
    (void)xcd_barrier_post((unsigned*)(a.ws + WS_BAR), (volatile LAS unsigned*)(ldsl + LDS_BYTES - 64));
#define GSYNC() do { XcdBarrier b_; b_.bar = (unsigned*)(a.ws + WS_BAR); b_.x = xb_xcc_id(); b_.st = (volatile LAS unsigned*)(ldsl + LDS_BYTES - 64); xcd_barrier(b_); } while (0)
#define FRESH_TID() ({ int t_ = threadIdx.x; asm volatile("" : "+v"(t_)); t_; })
#define NORM_ROWS(src, dst, nrows) do { const int t_ = FRESH_TID(); norm_rows(src, dst, nrows, cb_ * 8 + (t_ >> 6), NGW, t_ & 63); } while (0)
    unsigned char* ws = a.ws;
    const float* x_in = a.in[0]; float* X = a.out;
    float* lamv = (float*)(ws + WS_LAM); float* tabs = (float*)(ws + WS_TAB);
    bf16_t* WT = (bf16_t*)(ws + WS_WT);
    bf16_t* XH = (bf16_t*)(ws + WS_XH); bf16_t* MIX = (bf16_t*)(ws + WS_MIX); bf16_t* P = (bf16_t*)(ws + WS_P); bf16_t* VT = (bf16_t*)(ws + WS_VT);
    unsigned* BITS = (unsigned*)(ws + WS_BITS); bf16_t* MEMK = (bf16_t*)(ws + WS_MEMK); bf16_t* MEMVT = (bf16_t*)(ws + WS_MEMVT); bf16_t* MEMH = (bf16_t*)(ws + WS_MEMH);
    float* SS0 = (float*)(ws + WS_SS); float* SS1 = SS0 + (size_t)MTOK * 16; float* SS2 = SS1 + (size_t)MTOK * 16;
    bf16_t* GB = (bf16_t*)(ws + WS_G); bf16_t* FB = (bf16_t*)(ws + WS_FB); bf16_t* HB = (bf16_t*)(ws + WS_HB); bf16_t* QM = (bf16_t*)(ws + WS_QM);
    bf16_t* wt_in = (bf16_t*)((unsigned char*)WT + WT_IN); bf16_t* wt_out = (bf16_t*)((unsigned char*)WT + WT_OUT); bf16_t* wt_mq = (bf16_t*)((unsigned char*)WT + WT_MQ);
    bf16_t* wt_mo = (bf16_t*)((unsigned char*)WT + WT_MO); bf16_t* wt_mkv = (bf16_t*)((unsigned char*)WT + WT_MKV); bf16_t* wt_up = (bf16_t*)((unsigned char*)WT + WT_UP); bf16_t* wt_dn = (bf16_t*)((unsigned char*)WT + WT_DN);

    {
        const int tid = FRESH_TID(), lane = tid & 63, wave = __builtin_amdgcn_readfirstlane(tid >> 6), gw = cb_ * 8 + wave, gtid = cb_ * 512 + tid;
        float* scr = (float*)(lds + wave * 8448);
#pragma unroll 1
        for (int it = gw; it < NLAYER * 8704; it += NGW) { const int l = it / 8704; int r = it - l * 8704;
            if (r < 1920) { conv_one(a.in[4] + (size_t)l * DM * NIN, DM, NIN, 0, NIN, a.in[3] + l * DM, wt_in + (size_t)l * NINP * DM, NINP, 1, r, scr, lane); continue; } r -= 1920;
            if (r < 512) { conv_one(a.in[10] + (size_t)l * DM * DM, DM, DM, 0, DM, nullptr, wt_out + (size_t)l * DM * DM, DM, 0, r, scr, lane); continue; } r -= 512;
            if (r < 512) { conv_one(a.in[13] + (size_t)l * DM * DM, DM, DM, 0, DM, a.in[11] + l * DM, wt_mq + (size_t)l * DM * DM, DM, 0, r, scr, lane); continue; } r -= 512;
            if (r < 512) { conv_one(a.in[15] + (size_t)l * DM * DM, DM, DM, 0, DM, nullptr, wt_mo + (size_t)l * DM * DM, DM, 0, r, scr, lane); continue; } r -= 512;
            if (r < 512) { conv_one(a.in[14] + (size_t)l * DM * 2048, DM, 2048, 0, 1024, a.in[12] + l * DM, wt_mkv + (size_t)(l * 1024) * DM, 1024, 0, r, scr, lane); continue; } r -= 512;
            if (r < 512) { conv_one(a.in[14] + (size_t)l * DM * 2048, DM, 2048, 1024, 1024, a.in[12] + l * DM, wt_mkv + (size_t)(4096 + l * 1024) * DM, 1024, 0, r, scr, lane); continue; } r -= 512;
            if (r < 2816) { conv_one(a.in[17] + (size_t)l * DM * FF2, DM, FF2, 0, FF2, a.in[16] + l * DM, wt_up + (size_t)l * FF2 * DM, FF2, 2, r, scr, lane); continue; } r -= 2816;
            conv_one(a.in[20] + (size_t)l * FF * DM, FF, DM, 0, DM, nullptr, wt_dn + (size_t)l * DM * FF, DM, 0, r, scr, lane);
        }
        for (int idx = gtid; idx < 12 * TABN; idx += NTHR) { const int h = idx / TABN, dist = (TABN - 1 - idx % TABN) - TABOFF; float v = NEGV;
            if (dist >= 0) { int bucket = dist;
                if (dist >= 16) { const float nf = (float)dist; const float t = logf(nf / 16.0f) / 4.852030263919617f * 16.0f; int lg = 16 + (int)t; bucket = lg < 31 ? lg : 31; }
                const float bias = a.in[2][bucket * 12 + h];
                if (h >= 4 && h < 8) { const int mult = (dist <= 128 ? 1 : 0) + (((dist & 3) == 0 && dist <= 512) ? 1 : 0) + (((dist & 15) == 0 && dist <= 2048) ? 1 : 0);
                    if (mult > 0) v = (bias + logf((float)mult)) * LOG2E; }
                else v = bias * LOG2E; }
            tabs[idx] = v; }
        if (cb_ == 0 && wave < NLAYER) { const int l = wave;
            const float s1 = wave_sum(a.in[5][l * 64 + lane] * a.in[6][l * 64 + lane]), s2 = wave_sum(a.in[7][l * 64 + lane] * a.in[8][l * 64 + lane]);
            if (lane == 0) lamv[l] = expf(s1) - expf(s2) + lam_init_of(l); }
        norm_rows(a.in[1], MEMH, MMEM, gw, NGW, lane);
        cast_rows(x_in, XH, (float*)(ws + WS_SS), MTOK, gw, NGW, lane);
    }
    grid.sync();
    { pg8::EpiStore E{MEMK, 4096, 0, MEMVT, MMEM, 16, 32, 4096, nullptr}; run_gemm(ldsl, MEMH, wt_mkv, MMEM, 8192, DM, E); }

#pragma unroll 1
    for (int l = 0; l < NLAYER; ++l) {
        { pg8::EpiStore E{P, PW, 1024, VT, MTOK, 0, 4, 0, SS0}; run_gemm(ldsl, XH, wt_in + (size_t)l * NINP * DM, MTOK, NINP, DM, E); }
        GSYNC();
        MixCtx mc{P, VT, MIX, tabs, BITS, a.in[9], lamv, l, (float*)(ws + WS_STASH), NTHR};
        for (int it = cb_; it < 4096; it += G) idx_unit(lds, P, it & 15, it >> 4, BITS);
        { int ph = -1; for (int it = cb_; it < 1024; it += G) { int b, h, qb; deal_unit(it, b, h, qb); unitA(lds, mc, b, h, qb, h != ph); ph = h; } }
        { int ph = -1; for (int it = cb_; it < 1024; it += G) { int b, h, qb; deal_unit(it, b, h, qb); unitB(lds, mc, b, h, qb, h != ph); ph = h; } }
        GSYNC();
        { int ph = -1; for (int it = cb_; it < 1024; it += G) { int b, h, qb; deal_unit(it, b, h, qb); unitC(lds, mc, b, h, qb, h != ph); ph = h; } }
        GSYNC();
        { pg8::EpiResid E{XH, DM, SS1}; run_gemm(ldsl, MIX, wt_out + (size_t)l * DM * DM, MTOK, DM, DM, E); }
        GSYNC();
        { pg8::EpiStore E{QM, DM, 0, nullptr, 0, 0, 0, 0, SS1}; run_gemm(ldsl, XH, wt_mq + (size_t)l * DM * DM, MTOK, DM, DM, E); }
        GSYNC();
        for (int it = cb_; it < 2048; it += G) { const int xcd_ = it & 7, jj_ = ((it >> 3) & 31) * 8 + (it >> 8); const int qb = jj_ & 15, rest = xcd_ * 16 + (jj_ >> 4);     unitM(lds, QM, MEMK, MEMVT, MIX, l, rest >> 3, (rest >> 1) & 3, rest & 1, qb); }
        GSYNC();
        { pg8::EpiResid E{XH, DM, SS2}; run_gemm(ldsl, MIX, wt_mo + (size_t)l * DM * DM, MTOK, DM, DM, E); }
        GSYNC();
        { pg8::EpiConv E{GB, FB, HB, a.in[18] + (size_t)l * 3 * FF2, a.in[19] + (size_t)l * FF2, SS2}; run_gemm(ldsl, XH, wt_up + (size_t)l * FF2 * DM, MTOK, FF2, DM, E); }
        GSYNC();
        { const int t_ = FRESH_TID(); conv_fix_phase(FB, HB, GB, a.in[18] + (size_t)l * 3 * FF2, a.in[19] + (size_t)l * FF2, cb_ * 512 + t_, NTHR); }
        GSYNC();
        { pg8::EpiResid E{XH, DM, SS0}; run_gemm(ldsl, GB, wt_dn + (size_t)l * DM * FF, MTOK, DM, FF, E); }
        GSYNC();
    }
    { const int t_ = FRESH_TID(); final_rows(XH, X, a.in[21], cb_ * 8 + (t_ >> 6), NGW, t_ & 63); }
}

extern "C" void kernel_launch(void* const* d_in, const int* in_sizes, int n_in, void* d_out, int out_size, void* d_ws, size_t ws_size, hipStream_t stream) {
    static int grid_blocks = 0;
    if (grid_blocks == 0) {
        if (n_in != 22 || out_size != MTOK * DM || ws_size < WS_END) { fprintf(stderr, "kernel_launch: unexpected shapes (n_in %d out %d ws %zu)\n", n_in, out_size, ws_size); grid_blocks = -1; return; }
        int dev = 0, cus = 0, per_cu = 0;
        hipGetDevice(&dev);
        hipDeviceGetAttribute(&cus, hipDeviceAttributeMultiprocessorCount, dev);
        if (hipFuncSetAttribute((const void*)fwd_kernel, hipFuncAttributeMaxDynamicSharedMemorySize, LDS_BYTES) != hipSuccess) { fprintf(stderr, "kernel_launch: hipFuncSetAttribute failed\n"); }
        if (hipOccupancyMaxActiveBlocksPerMultiprocessor(&per_cu, (const void*)fwd_kernel, 512, LDS_BYTES) != hipSuccess || per_cu < 1) { fprintf(stderr, "kernel_launch: occupancy query %d\n", per_cu); per_cu = 1; }
        (void)hipGetLastError();
        grid_blocks = cus * per_cu;
    }
    if (grid_blocks < 0) return;
    if (hipMemsetAsync((char*)d_ws + WS_BAR, 0, WS_BAR_BYTES, stream) != hipSuccess) { fprintf(stderr, "kernel_launch: memset failed\n"); return; }
    Args a{};
    for (int i = 0; i < 22; ++i) a.in[i] = (const float*)d_in[i];
    a.out = (float*)d_out; a.ws = (unsigned char*)d_ws;
    void* args[] = {&a};
    hipError_t e = hipLaunchCooperativeKernel((const void*)fwd_kernel, dim3(grid_blocks), dim3(512), args, LDS_BYTES, stream);
    if (e != hipSuccess) fprintf(stderr, "kernel_launch: cooperative launch failed: %s (grid %d)\n", hipGetErrorString(e), grid_blocks);
}
```

```cpp
#include <hip/hip_runtime.h>
#include <hip/hip_cooperative_groups.h>
#include <cstdio>
#include <cstdint>
namespace cg = cooperative_groups;

namespace pg8 {
#define PG8_LAS __attribute__((address_space(3)))
typedef unsigned short bf16_t;
typedef short bf16x8 __attribute__((ext_vector_type(8)));
typedef float f32x4 __attribute__((ext_vector_type(4)));
typedef unsigned u32x4 __attribute__((ext_vector_type(4)));
constexpr int BM = 256, BK = 64, HALF = 128, HTB = HALF * BK * 2  , STAGE_BYTES = 8 * HTB, NXCD = 8, WGM = 8;

__host__ __device__ __forceinline__ int lds_byte(int r, int c) { const int st = (r >> 4) * 2 + (c >> 5), rr = r & 15, cc = c & 31, ob = rr * 64 + cc * 2; return st * 1024 + (ob ^ (((ob >> 9) & 1) << 5)); }
__host__ __device__ __forceinline__ void stage_rc(int b, int& R, int& C) { const int st = b / 1024, sb = b % 1024, swz = sb ^ (((sb >> 9) & 1) << 5); R = (st >> 1) * 16 + swz / 64; C = (st & 1) * 32 + (swz % 64) / 2; }
__host__ __device__ __forceinline__ int perm32(int rho) { const int n = rho >> 4, i = rho & 15; return 8 * (i >> 2) + 4 * n + (i & 3); }

struct Unit { int pm, pn; };
struct Gemm { const bf16_t* A; const bf16_t* Bt; int M, N, K; };

struct StaticOrder {
    int nM, nN, nwg, G, c;
    __host__ __device__ void init(int M, int N, int G_, int c_) { nM = M / BM; nN = N / BM; nwg = nM * nN; G = G_; c = c_; }
    __host__ __device__ bool next(int i, Unit& u) const {
        const long L = (long)i * G + c; if (L >= nwg) return false;
        int wgid = (int)L; { const int q = nwg / NXCD, r = nwg % NXCD, xcd = wgid % NXCD, off = wgid / NXCD; wgid = (xcd < r ? xcd * (q + 1) : r * (q + 1) + (xcd - r) * q) + off; }
        const int nig = WGM * nN, gid = wgid / nig, fm = gid * WGM, gsz = (nM - fm) < WGM ? (nM - fm) : WGM;
        u.pm = fm + ((wgid % nig) % gsz); u.pn = (wgid % nig) / gsz; return true;
    }
    __device__ __forceinline__ void a_ready(const Unit&) const {}
    __device__ __forceinline__ void done(const Unit&) const {}
};

__device__ __forceinline__ unsigned cvt_pk_bf16(float lo, float hi) { unsigned r; asm volatile("v_cvt_pk_bf16_f32 %0, %1, %2" : "=v"(r) : "v"(lo), "v"(hi)); return r; }
__device__ __forceinline__ void load_row_scales(const float* ssp, int row0, int fq, float (&rs)[2][4]) {
    f32x4 part[2][4];
    const float* sp = ssp + (size_t)row0 * 16 + 4 * fq;
#pragma unroll
    for (int ai = 0; ai < 2; ++ai)
#pragma unroll
        for (int m = 0; m < 4; ++m) part[ai][m] = *(const f32x4*)(sp + (size_t)(ai * HALF + m * 16) * 16);
#pragma unroll
    for (int ai = 0; ai < 2; ++ai)
#pragma unroll
        for (int m = 0; m < 4; ++m) { float t = (part[ai][m][0] + part[ai][m][1]) + (part[ai][m][2] + part[ai][m][3]);
            t += __shfl_xor(t, 16); t += __shfl_xor(t, 32);
            rs[ai][m] = 1.0f / sqrtf(t * (1.0f / 1024.0f) + 1e-6f); }
}
struct EpiStore {
    static constexpr bool PERM = true, AFTER_DRAIN = false;
    bf16_t* R; int ldr; int r_col0; bf16_t* T; int ldt; int t_lo, t_hi, t_col0; const float* ssp;
    __device__ __forceinline__ float row_rs(const float* sp) const {
        const f32x4 a = *(const f32x4*)sp, b = *(const f32x4*)(sp + 4), c = *(const f32x4*)(sp + 8), d = *(const f32x4*)(sp + 12);
        const float tot = ((a[0] + a[1]) + (a[2] + a[3])) + ((b[0] + b[1]) + (b[2] + b[3])) + ((c[0] + c[1]) + (c[2] + c[3])) + ((d[0] + d[1]) + (d[2] + d[3]));
        return 1.0f / sqrtf(tot * (1.0f / 1024.0f) + 1e-6f);
    }
    __device__ __forceinline__ void operator()(f32x4 (&acc)[2][2][4][2], const Unit& u, int wr, int wc, int fr, int fq) const {
        const int row0 = u.pm * BM + wr * 64 + fr;
        const int colt = u.pn * BM + wc * 32 + 8 * fq;
        if (u.pn >= t_lo && u.pn < t_hi) {
            if (ssp) { float rs[2][4]; load_row_scales(ssp, row0, fq, rs);
#pragma unroll
                for (int ai = 0; ai < 2; ++ai)
#pragma unroll
                    for (int m = 0; m < 4; ++m)
#pragma unroll
                        for (int bj = 0; bj < 2; ++bj)
#pragma unroll
                            for (int n = 0; n < 2; ++n) acc[ai][bj][m][n] = acc[ai][bj][m][n] * rs[ai][m];
            }
            bf16_t* tp = T + (size_t)(colt - t_col0) * ldt + row0;
#pragma unroll
            for (int bj = 0; bj < 2; ++bj) {
#pragma unroll
                for (int n = 0; n < 2; ++n)
#pragma unroll
                    for (int j = 0; j < 4; ++j) {
#pragma unroll
                        for (int ai = 0; ai < 2; ++ai)
#pragma unroll
                            for (int m = 0; m < 4; ++m) tp[ai * HALF + m * 16] = (bf16_t)(cvt_pk_bf16(acc[ai][bj][m][n][j], 0.f) & 0xffffu);
                        tp += ldt; asm volatile("" : "+v"(tp)); }
                tp += (size_t)120 * ldt; asm volatile("" : "+v"(tp)); }
        } else {
            bf16_t* rowp = R + (size_t)row0 * ldr + (colt - r_col0);
            float rsa[2][4];
            if (ssp) load_row_scales(ssp, row0, fq, rsa);
            else {
#pragma unroll
                for (int ai = 0; ai < 2; ++ai)
#pragma unroll
                    for (int m = 0; m < 4; ++m) rsa[ai][m] = 1.0f; }
#pragma unroll
            for (int ai = 0; ai < 2; ++ai) {
#pragma unroll
                for (int m = 0; m < 4; ++m) { const float rs = rsa[ai][m];
#pragma unroll
                    for (int bj = 0; bj < 2; ++bj) { const f32x4 v0 = acc[ai][bj][m][0] * rs, v1 = acc[ai][bj][m][1] * rs;
                        u32x4 w; w.x = cvt_pk_bf16(v0[0], v0[1]); w.y = cvt_pk_bf16(v0[2], v0[3]); w.z = cvt_pk_bf16(v1[0], v1[1]); w.w = cvt_pk_bf16(v1[2], v1[3]);
                        *(u32x4*)(rowp + bj * HALF) = w; }
                    rowp += (size_t)16 * ldr; asm volatile("" : "+v"(rowp) :: "memory"); }
                rowp += (size_t)64 * ldr; asm volatile("" : "+v"(rowp)); }
        }
    }
};
struct EpiResid {
    static constexpr bool PERM = false, AFTER_DRAIN = false;
    bf16_t* xb; int ldc; float* ssp;
    __device__ __forceinline__ void operator()(f32x4 (&acc)[2][2][4][2], const Unit& u, int wr, int wc, int fr, int fq) const {
        const int col0 = u.pn * BM + wc * 32 + 4 * fq;
#pragma unroll
        for (int ai = 0; ai < 2; ++ai) {
            unsigned long long old[4][2][2];
#pragma unroll
            for (int m = 0; m < 4; ++m) { const size_t off = (size_t)(u.pm * BM + ai * HALF + wr * 64 + m * 16 + fr) * ldc + col0;
#pragma unroll
                for (int bj = 0; bj < 2; ++bj)
#pragma unroll
                    for (int n = 0; n < 2; ++n) old[m][bj][n] = *(const unsigned long long*)(xb + off + bj * HALF + n * 16); }
#pragma unroll
            for (int m = 0; m < 4; ++m) { const int row = u.pm * BM + ai * HALF + wr * 64 + m * 16 + fr; const size_t off = (size_t)row * ldc + col0; float sq = 0.f;
#pragma unroll
                for (int bj = 0; bj < 2; ++bj)
#pragma unroll
                    for (int n = 0; n < 2; ++n) { const unsigned long long b = old[m][bj][n];
                        const unsigned blo = (unsigned)b, bhi = (unsigned)(b >> 32);
                        f32x4 v; v[0] = __builtin_bit_cast(float, blo << 16); v[1] = __builtin_bit_cast(float, blo & 0xffff0000u); v[2] = __builtin_bit_cast(float, bhi << 16); v[3] = __builtin_bit_cast(float, bhi & 0xffff0000u);
                        v = v + acc[ai][bj][m][n];
                        sq += (v[0] * v[0] + v[1] * v[1]) + (v[2] * v[2] + v[3] * v[3]);
                        *(unsigned long long*)(xb + off + bj * HALF + n * 16) = (unsigned long long)cvt_pk_bf16(v[0], v[1]) | ((unsigned long long)cvt_pk_bf16(v[2], v[3]) << 32); }
                sq += __shfl_xor(sq, 16); sq += __shfl_xor(sq, 32);
                if (fq == 0) ssp[(size_t)row * 16 + 4 * u.pn + wc] = sq; }
            asm volatile("" ::: "memory"); }
    }
};
__device__ __forceinline__ float dppf(float old, float src, int ctrl_sel) {
    const int o = __builtin_bit_cast(int, old), v = __builtin_bit_cast(int, src); int r;
    if (ctrl_sel == 0) r = __builtin_amdgcn_update_dpp(o, v, 0x111, 0xf, 0xf, false);
    else if (ctrl_sel == 1) r = __builtin_amdgcn_update_dpp(o, v, 0x112, 0xf, 0xf, false);
    else if (ctrl_sel == 2) r = __builtin_amdgcn_update_dpp(o, v, 0x121, 0xf, 0xf, false);
    else r = __builtin_amdgcn_update_dpp(o, v, 0x122, 0xf, 0xf, false);
    return __builtin_bit_cast(float, r);
}
struct EpiConv {
    static constexpr bool PERM = true, AFTER_DRAIN = false;
    bf16_t* G; bf16_t* Fb; bf16_t* Hb; const float* cw; const float* cb; const float* ssp;
    __device__ __forceinline__ void operator()(f32x4 (&acc)[2][2][4][2], const Unit& u, int wr, int wc, int fr, int fq) const {
        constexpr int FFc = 2816, FF2c = 5632;
        const int row0 = u.pm * BM + wr * 64 + fr;
        { float rs[2][4]; load_row_scales(ssp, row0, fq, rs);
#pragma unroll
          for (int ai = 0; ai < 2; ++ai)
#pragma unroll
              for (int m = 0; m < 4; ++m)
#pragma unroll
                  for (int bj = 0; bj < 2; ++bj)
#pragma unroll
                      for (int n = 0; n < 2; ++n) acc[ai][bj][m][n] = acc[ai][bj][m][n] * rs[ai][m]; }
#pragma unroll
        for (int n = 0; n < 2; ++n) {
            const int gc0 = u.pn * 128 + wc * 32 + 8 * fq + 4 * n;
            const float* cwp = cw + gc0; asm volatile("" : "+v"(cwp));
            const f32x4 wg0 = *(const f32x4*)(cwp), wg1 = *(const f32x4*)(cwp + FF2c), wg2 = *(const f32x4*)(cwp + 2 * FF2c);
            const f32x4 wv0 = *(const f32x4*)(cwp + FFc), wv1 = *(const f32x4*)(cwp + FF2c + FFc), wv2 = *(const f32x4*)(cwp + 2 * FF2c + FFc);
            const f32x4 bg = *(const f32x4*)(cb + gc0), bv = *(const f32x4*)(cb + FFc + gc0);
            bf16_t* gp = G + (size_t)row0 * FFc + gc0;
            bf16_t* sb = Fb + ((size_t)(row0 >> 6) * 2 + (fr & 1)) * FF2c + gc0;
            bf16_t* hb = Hb + ((size_t)(row0 >> 6) * 2 + (fr & 1)) * FF2c + gc0;
#pragma unroll
            for (int ai = 0; ai < 2; ++ai) {
#pragma unroll
                for (int m = 0; m < 4; ++m) {
                    float og[4];
#pragma unroll
                    for (int j = 0; j < 4; ++j) {
                        const float vg = acc[ai][0][m][n][j], vv = acc[ai][1][m][n][j];
                        const float pg = (m > 0) ? acc[ai][0][m - 1][n][j] : 0.f, pv = (m > 0) ? acc[ai][1][m - 1][n][j] : 0.f;
                        const float g1 = dppf(dppf(0.f, pg, 2), vg, 0), g2 = dppf(dppf(0.f, pg, 3), vg, 1);
                        const float v1 = dppf(dppf(0.f, pv, 2), vv, 0), v2 = dppf(dppf(0.f, pv, 3), vv, 1);
                        const float cgate = bg[j] + wg0[j] * g2 + wg1[j] * g1 + wg2[j] * vg;
                        const float cval = bv[j] + wv0[j] * v2 + wv1[j] * v1 + wv2[j] * vv;
                        og[j] = cgate * __builtin_amdgcn_rcpf(1.0f + __builtin_amdgcn_exp2f(-1.4426950408889634f * cgate)) * cval; }
                    const unsigned long long w = (unsigned long long)cvt_pk_bf16(og[0], og[1]) | ((unsigned long long)cvt_pk_bf16(og[2], og[3]) << 32);
                    if (m == 0) {
                        if (fr >= 2) *(unsigned long long*)gp = w;
                        else { *(unsigned long long*)sb = (unsigned long long)cvt_pk_bf16(acc[ai][0][0][n][0], acc[ai][0][0][n][1]) | ((unsigned long long)cvt_pk_bf16(acc[ai][0][0][n][2], acc[ai][0][0][n][3]) << 32);
                               *(unsigned long long*)(sb + FFc) = (unsigned long long)cvt_pk_bf16(acc[ai][1][0][n][0], acc[ai][1][0][n][1]) | ((unsigned long long)cvt_pk_bf16(acc[ai][1][0][n][2], acc[ai][1][0][n][3]) << 32); }
                    } else *(unsigned long long*)gp = w;
                    if (m == 3 && fr >= 14) {
                        *(unsigned long long*)hb = (unsigned long long)cvt_pk_bf16(acc[ai][0][3][n][0], acc[ai][0][3][n][1]) | ((unsigned long long)cvt_pk_bf16(acc[ai][0][3][n][2], acc[ai][0][3][n][3]) << 32);
                        *(unsigned long long*)(hb + FFc) = (unsigned long long)cvt_pk_bf16(acc[ai][1][3][n][0], acc[ai][1][3][n][1]) | ((unsigned long long)cvt_pk_bf16(acc[ai][1][3][n][2], acc[ai][1][3][n][3]) << 32); }
                    gp += (size_t)16 * FFc; asm volatile("" : "+v"(gp) :: "memory"); }
                gp += (size_t)64 * FFc; sb += (size_t)4 * FF2c; hb += (size_t)4 * FF2c; asm volatile("" : "+v"(gp), "+v"(sb), "+v"(hb)); }
        }
    }
};

template <class Epi, class Sched, bool ALIGN_EPI = false, bool SP2 = false>
__device__ __forceinline__ void gemm_phase(PG8_LAS unsigned char* lds, const Gemm g, const Sched& S, const Epi& E) {
    int tid_o = threadIdx.x; asm volatile("" : "+v"(tid_o));
    const int tid = tid_o, wid = __builtin_amdgcn_readfirstlane(tid >> 6), lane = tid & 63, wr = wid >> 2, wc = wid & 3, fr = lane & 15, fq = lane >> 4;
    const int K = g.K, nt = K / BK;
    unsigned voffA[2], voffB[2];
#pragma unroll
    for (int i = 0; i < 2; ++i) { int R, C; stage_rc(tid * 16 + i * 8192, R, C); const int Rb = Epi::PERM ? ((R & ~31) + perm32(R & 31)) : R;
        voffA[i] = (unsigned)(R * K + C) * 2u; voffB[i] = (unsigned)(Rb * K + C) * 2u; }
    const size_t kstep = (size_t)(BK * 2);
    const size_t hstep = (size_t)HALF * K * 2;
    const size_t tstep = 2 * hstep;
    const unsigned ldsw = (unsigned)wid * 1024u;
    const int aoff = lds_byte(wr * 64 + fr, fq * 8), boff = lds_byte(wc * 32 + fr, fq * 8);
#define PG8_SA(b, h) (((b) * 2 + (h)) * HTB)
#define PG8_SB(b, h) ((4 + (b) * 2 + (h)) * HTB)
#define PG8_STAGE(bufoff, gbase, voff) do { _Pragma("unroll") for (int _i = 0; _i < 2; ++_i) \
        __builtin_amdgcn_global_load_lds((const unsigned*)((const char*)(gbase) + (voff)[_i]), (PG8_LAS unsigned*)(lds + (bufoff) + ldsw + _i * 8192), 16, 0, 0); } while (0)
#define PG8_LDA(dst, b, h) do { _Pragma("unroll") for (int m = 0; m < 4; ++m) _Pragma("unroll") for (int k = 0; k < 2; ++k) dst[m][k] = *(const PG8_LAS bf16x8*)(lds + PG8_SA(b, h) + aoff + m * 2048 + k * 1024); } while (0)
#define PG8_LDB(dst, b, h) do { _Pragma("unroll") for (int n = 0; n < 2; ++n) _Pragma("unroll") for (int k = 0; k < 2; ++k) dst[n][k] = *(const PG8_LAS bf16x8*)(lds + PG8_SB(b, h) + boff + n * 2048 + k * 1024); } while (0)
#define PG8_MMA(ai, bj, At, Bt) do { __builtin_amdgcn_s_setprio(1); _Pragma("unroll") for (int m = 0; m < 4; ++m) _Pragma("unroll") for (int n = 0; n < 2; ++n) _Pragma("unroll") for (int k = 0; k < 2; ++k) \
        acc[ai][bj][m][n] = __builtin_amdgcn_mfma_f32_16x16x32_bf16(Bt[n][k], At[m][k], acc[ai][bj][m][n], 0, 0, 0); __builtin_amdgcn_s_setprio(0); } while (0)
#define PG8_WAIT_V(n) asm volatile("s_waitcnt vmcnt(" #n ")" ::: "memory")
#define PG8_WAIT_L(n) asm volatile("s_waitcnt lgkmcnt(" #n ")" ::: "memory")
#define PG8_BAR __builtin_amdgcn_s_barrier()
#define PG8_SCHED __builtin_amdgcn_sched_barrier(0)
    Unit cur, nxt; int ui = 0;
    if (!S.next(0, cur)) return;
    f32x4 acc[2][2][4][2];
#pragma unroll
    for (int a = 0; a < 2; ++a)
#pragma unroll
        for (int b = 0; b < 2; ++b)
#pragma unroll
            for (int m = 0; m < 4; ++m)
#pragma unroll
                for (int n = 0; n < 2; ++n) acc[a][b][m][n] = (f32x4){0.f, 0.f, 0.f, 0.f};
    bf16x8 At[4][2], B0[2][2], B1[2][2];
    const char* cA = (const char*)g.A + (size_t)cur.pm * tstep; const char* cB = (const char*)g.Bt + (size_t)cur.pn * tstep;
    S.a_ready(cur);
    if constexpr (SP2) {
        PG8_STAGE(PG8_SB(0, 0), cB, voffB); PG8_STAGE(PG8_SB(0, 1), cB + hstep, voffB); PG8_STAGE(PG8_SA(0, 0), cA, voffA); PG8_STAGE(PG8_SA(0, 1), cA + hstep, voffA);
        if (wr == 1) PG8_BAR;
        PG8_WAIT_V(2); PG8_BAR;
        PG8_STAGE(PG8_SB(1, 0), cB + kstep, voffB); PG8_STAGE(PG8_SA(1, 0), cA + kstep, voffA); PG8_STAGE(PG8_SB(1, 1), cB + hstep + kstep, voffB);
        PG8_WAIT_V(6); PG8_BAR;
    } else {
        PG8_STAGE(PG8_SB(0, 0), cB, voffB); PG8_STAGE(PG8_SA(0, 0), cA, voffA); PG8_STAGE(PG8_SB(0, 1), cB + hstep, voffB); PG8_STAGE(PG8_SA(0, 1), cA + hstep, voffA);
        if (wr == 1) PG8_BAR;
        PG8_WAIT_V(4); PG8_BAR;
        PG8_STAGE(PG8_SB(1, 0), cB + kstep, voffB); PG8_STAGE(PG8_SA(1, 0), cA + kstep, voffA); PG8_STAGE(PG8_SB(1, 1), cB + hstep + kstep, voffB);
        PG8_WAIT_V(6); PG8_BAR;
    }
    for (;;) {
        const bool has_next = S.next(ui + 1, nxt);
        const char* nA = has_next ? (const char*)g.A + (size_t)nxt.pm * tstep : cA; const char* nB = has_next ? (const char*)g.Bt + (size_t)nxt.pn * tstep : cB;
        for (int t = 0; t < nt; t += 2) {
            const bool last = (t == nt - 2);
            const char* a1 = cA + (size_t)(t + 1) * kstep;
            const char* a2 = last ? nA : cA + (size_t)(t + 2) * kstep; const char* b2 = last ? nB : cB + (size_t)(t + 2) * kstep;
            const char* a3 = a2 + kstep; const char* b3 = b2 + kstep;
            if (last && has_next) S.a_ready(nxt);
            if constexpr (SP2) {
            PG8_LDB(B0, 0, 0); PG8_LDB(B1, 0, 1); PG8_SCHED; PG8_LDA(At, 0, 0); PG8_STAGE(PG8_SA(1, 1), a1 + hstep, voffA);
            PG8_WAIT_V(8); PG8_WAIT_L(0); PG8_BAR; PG8_MMA(0, 0, At, B0); PG8_MMA(0, 1, At, B1); PG8_BAR; PG8_SCHED;
            PG8_LDA(At, 0, 1); PG8_STAGE(PG8_SB(0, 0), b2, voffB); PG8_STAGE(PG8_SB(0, 1), b2 + hstep, voffB); PG8_STAGE(PG8_SA(0, 0), a2, voffA);
            PG8_WAIT_V(8); PG8_WAIT_L(0); PG8_BAR; PG8_MMA(1, 0, At, B0); PG8_MMA(1, 1, At, B1); PG8_BAR; PG8_SCHED;
            PG8_LDB(B0, 1, 0); PG8_LDB(B1, 1, 1); PG8_SCHED; PG8_LDA(At, 1, 0); PG8_STAGE(PG8_SA(0, 1), a2 + hstep, voffA);
            PG8_WAIT_V(8); PG8_WAIT_L(0); PG8_BAR; PG8_MMA(0, 0, At, B0); PG8_MMA(0, 1, At, B1); PG8_BAR; PG8_SCHED;
            PG8_LDA(At, 1, 1); PG8_STAGE(PG8_SB(1, 0), b3, voffB); PG8_STAGE(PG8_SB(1, 1), b3 + hstep, voffB); PG8_STAGE(PG8_SA(1, 0), a3, voffA);
            PG8_WAIT_V(8); PG8_WAIT_L(0); PG8_BAR; PG8_MMA(1, 0, At, B0); PG8_MMA(1, 1, At, B1); PG8_BAR; PG8_SCHED;
            } else {
            PG8_LDB(B0, 0, 0); PG8_SCHED; PG8_LDA(At, 0, 0); PG8_STAGE(PG8_SA(1, 1), a1 + hstep, voffA);
            PG8_WAIT_L(8); PG8_BAR; PG8_WAIT_L(0); PG8_MMA(0, 0, At, B0); PG8_BAR; PG8_SCHED;
            PG8_LDB(B1, 0, 1); PG8_STAGE(PG8_SB(0, 0), b2, voffB);
            PG8_BAR; PG8_WAIT_L(0); PG8_MMA(0, 1, At, B1); PG8_BAR;
            PG8_LDA(At, 0, 1); PG8_STAGE(PG8_SA(0, 0), a2, voffA);
            PG8_BAR; PG8_WAIT_L(0); PG8_MMA(1, 0, At, B0); PG8_BAR; PG8_SCHED;
            PG8_STAGE(PG8_SB(0, 1), b2 + hstep, voffB);
            PG8_WAIT_V(6); PG8_BAR; PG8_MMA(1, 1, At, B1); PG8_BAR;
            PG8_LDB(B0, 1, 0); PG8_SCHED; PG8_LDA(At, 1, 0); PG8_STAGE(PG8_SA(0, 1), a2 + hstep, voffA);
            PG8_WAIT_L(8); PG8_BAR; PG8_WAIT_L(0); PG8_MMA(0, 0, At, B0); PG8_BAR; PG8_SCHED;
            PG8_LDB(B1, 1, 1); PG8_STAGE(PG8_SB(1, 0), b3, voffB);
            PG8_BAR; PG8_WAIT_L(0); PG8_MMA(0, 1, At, B1); PG8_BAR;
            PG8_LDA(At, 1, 1); PG8_STAGE(PG8_SA(1, 0), a3, voffA);
            PG8_BAR; PG8_WAIT_L(0); PG8_MMA(1, 0, At, B0); PG8_BAR; PG8_SCHED;
            PG8_STAGE(PG8_SB(1, 1), b3 + hstep, voffB);
            PG8_WAIT_V(6); PG8_BAR; PG8_MMA(1, 1, At, B1); PG8_BAR;
            }
        }
        if constexpr (ALIGN_EPI) { if (wr == 0) PG8_BAR; }
        if constexpr (!Epi::AFTER_DRAIN) { E(acc, cur, wr, wc, fr, fq); S.done(cur); }
        if (!has_next) break;
#pragma unroll
        for (int a = 0; a < 2; ++a)
#pragma unroll
            for (int b = 0; b < 2; ++b)
#pragma unroll
                for (int m = 0; m < 4; ++m)
#pragma unroll
                    for (int n = 0; n < 2; ++n) acc[a][b][m][n] = (f32x4){0.f, 0.f, 0.f, 0.f};
        cur = nxt; cA = nA; cB = nB; ++ui;
        if constexpr (ALIGN_EPI) { if (wr == 1) PG8_BAR; }
    }
    PG8_WAIT_V(0);
    if constexpr (!ALIGN_EPI) { if (wr == 0) PG8_BAR; }
    PG8_BAR;
    if constexpr (Epi::AFTER_DRAIN) { E.fused(acc, cur, wr, wc, fr, fq, lds, wid, lane); S.done(cur); }
#undef PG8_SA
#undef PG8_SB
#undef PG8_STAGE
#undef PG8_LDA
#undef PG8_LDB
#undef PG8_MMA
#undef PG8_WAIT_V
#undef PG8_WAIT_L
#undef PG8_BAR
#undef PG8_SCHED
}
}

#define LAS __attribute__((address_space(3)))
using pg8::bf16_t;
typedef short bf16x8 __attribute__((ext_vector_type(8)));
typedef short s16x4 __attribute__((ext_vector_type(4)));
typedef float f32x16 __attribute__((ext_vector_type(16)));
typedef float f32x4 __attribute__((ext_vector_type(4)));
typedef float f32x2_t __attribute__((ext_vector_type(2)));
typedef __bf16 bf16x2_t __attribute__((ext_vector_type(2)));
typedef unsigned u32x4v __attribute__((ext_vector_type(4)));
typedef unsigned u32x2v __attribute__((ext_vector_type(2)));

constexpr int NB = 16, SEQ = 4096, DM = 1024, MTOK = NB * SEQ, NLAYER = 4, MEMLEN = 256, MMEM = NB * MEMLEN;
constexpr int NIN = 3656, NINP = 3840, PW = 2816, FF = 2816, FF2 = 5632;
constexpr int P_AQ = 0, P_AK = 512, P_BQ = 1024, P_BK = 1280, P_CQ = 1536, P_CK = 1792, P_IQ = 2048, P_IK = 2560, P_IW = 2624;
constexpr int V_A = 0, V_B = 512, V_C = 768;
constexpr int TABN = 4352, TABOFF = 256;
constexpr float NEGV = -1.0e30f, LOG2E = 1.4426950408889634f, EPSN = 1e-6f;
constexpr int FCH = 2, FROWS = MTOK / FCH;

constexpr size_t MiB = (size_t)1 << 20;
constexpr size_t WS_LAM = 0, WS_BAR = 4096, WS_BAR_BYTES = 16384, WS_TAB = 65536, WS_WT = 2 * MiB;
constexpr size_t WT_IN = 0, WT_OUT = 30 * MiB, WT_MQ = 38 * MiB, WT_MO = 46 * MiB, WT_MKV = 54 * MiB, WT_UP = 70 * MiB, WT_DN = 114 * MiB;
constexpr size_t WS_XH = 138 * MiB, WS_MIX = 266 * MiB, WS_P = 394 * MiB, WS_VT = 746 * MiB, WS_BITS = 874 * MiB, WS_MEMK = 906 * MiB, WS_MEMVT = 938 * MiB, WS_MEMH = 970 * MiB, WS_STASH = 978 * MiB, WS_SS = 1010 * MiB, WS_END = 1022 * MiB;
constexpr size_t WS_G = WS_MIX, WS_FB = WS_MIX + 352 * MiB, WS_HB = WS_FB + 22 * MiB, WS_QM = WS_P;
constexpr int LDS_BYTES = 147456;

__device__ __forceinline__ unsigned cvtpk(float lo, float hi) { f32x2_t v = {lo, hi}; bf16x2_t b = __builtin_convertvector(v, bf16x2_t); return __builtin_bit_cast(unsigned, b); }
__device__ __forceinline__ float bf2f(bf16_t v) { return __builtin_bit_cast(float, (unsigned)v << 16); }
__device__ __forceinline__ float swap32_add(float v) { auto rr = __builtin_amdgcn_permlane32_swap(__float_as_uint(v), __float_as_uint(v), false, false); return __uint_as_float(rr[0]) + __uint_as_float(rr[1]); }
__device__ __forceinline__ float swap32_max(float v) { auto rr = __builtin_amdgcn_permlane32_swap(__float_as_uint(v), __float_as_uint(v), false, false); return fmaxf(__uint_as_float(rr[0]), __uint_as_float(rr[1])); }
__device__ __forceinline__ float max3f(float a, float b, float c) { float r; asm("v_max3_f32 %0, %1, %2, %3" : "=v"(r) : "v"(a), "v"(b), "v"(c)); return r; }
__device__ __forceinline__ float reluf(float a) { float r; asm("v_max_f32_e32 %0, 0, %1" : "=v"(r) : "v"(a)); return r; }
__device__ __forceinline__ float wave_sum(float v) {
#pragma unroll
    for (int o = 1; o < 64; o <<= 1) v += __shfl_xor(v, o);
    return v;
}

__device__ __forceinline__ void conv_item(const float* W, int ldw, int srccol0, int nvalid, const float* gain, bf16_t* dst, int K, int k0, float* scr, int lane) {
    const int c4 = (lane & 7) * 4, kr = lane >> 3;
    if (nvalid == 32 && ((ldw | srccol0) & 3) == 0) {
#pragma unroll
        for (int i = 0; i < 8; ++i) { const int kk = 8 * i + kr; f32x4 v = *(const f32x4*)(W + (size_t)(k0 + kk) * ldw + srccol0 + c4);
            if (gain) v = v * gain[k0 + kk];
            scr[kk * 33 + c4] = v[0]; scr[kk * 33 + c4 + 1] = v[1]; scr[kk * 33 + c4 + 2] = v[2]; scr[kk * 33 + c4 + 3] = v[3]; }
    } else {
#pragma unroll 8
        for (int i = 0; i < 32; ++i) { const int kk = 2 * i + (lane >> 5), c = lane & 31;
            float v = (c < nvalid) ? W[(size_t)(k0 + kk) * ldw + srccol0 + c] : 0.f;
            if (gain) v *= gain[k0 + kk];
            scr[kk * 33 + c] = v; }
    }
    __builtin_amdgcn_fence(__ATOMIC_RELEASE, "wavefront"); __builtin_amdgcn_wave_barrier();
    const int c8 = lane & 7;
#pragma unroll
    for (int j = 0; j < 4; ++j) { const int n = (lane >> 3) + 8 * j; const float* sp = scr + (8 * c8) * 33 + n;
        u32x4v o; o.x = cvtpk(sp[0 * 33], sp[1 * 33]); o.y = cvtpk(sp[2 * 33], sp[3 * 33]); o.z = cvtpk(sp[4 * 33], sp[5 * 33]); o.w = cvtpk(sp[6 * 33], sp[7 * 33]);
        *(u32x4v*)(dst + (size_t)n * K + k0 + 8 * c8) = o; }
    __builtin_amdgcn_fence(__ATOMIC_RELEASE, "wavefront"); __builtin_amdgcn_wave_barrier();
}
__device__ __forceinline__ int win_map(int n0) {
    if (n0 < 512) return 1024 + n0;
    if (n0 < 768) return 2048 + (n0 - 512);
    if (n0 < 1024) return 2816 + (n0 - 768);
    if (n0 < 2048) return n0 - 1024;
    if (n0 < 2560) return n0 - 512;
    if (n0 < 3072) return n0 - 256;
    return n0;
}
__device__ __forceinline__ void conv_one(const float* W, int K, int Nsrc, int srccol0, int ncols_src, const float* gain, bf16_t* dst, int Ndst, int map, int it, float* scr, int lane) {
    const int nblk = Ndst / 32; const int kb = it / nblk, nb = it % nblk, n0 = nb * 32;
    int sc, nv;
    if (map == 1) { sc = win_map(n0); nv = Nsrc - sc; } else if (map == 2) { const int tl = n0 >> 8, wi = n0 & 255; sc = wi < 128 ? tl * 128 + wi : FF + tl * 128 + (wi - 128); nv = 32; } else { sc = srccol0 + n0; nv = ncols_src - n0; }
    nv = nv < 0 ? 0 : (nv > 32 ? 32 : nv);
    conv_item(W, Nsrc, sc, nv, gain, dst + (size_t)n0 * K, K, kb * 64, scr, lane);
}
__device__ __forceinline__ void conv_mat(const float* W, int K, int Nsrc, int srccol0, int ncols_src, const float* gain, bf16_t* dst, int Ndst, int map, int gw, int NGW, float* scr, int lane) {
    const int nblk = Ndst / 32, nitems = (K / 64) * nblk;
    for (int it = gw; it < nitems; it += NGW) { const int kb = it / nblk, nb = it % nblk, n0 = nb * 32;
        int sc, nv;
        if (map == 1) { sc = win_map(n0); nv = Nsrc - sc; } else if (map == 2) { const int tl = n0 >> 8, wi = n0 & 255; sc = wi < 128 ? tl * 128 + wi : FF + tl * 128 + (wi - 128); nv = 32; } else { sc = srccol0 + n0; nv = ncols_src - n0; }
        nv = nv < 0 ? 0 : (nv > 32 ? 32 : nv);
        conv_item(W, Nsrc, sc, nv, gain, dst + (size_t)n0 * K, K, kb * 64, scr, lane); }
}
__device__ __forceinline__ void norm_rows(const float* X, bf16_t* XH, int nrows, int gw, int NGW, int lane) {
    for (int m = gw; m < nrows; m += NGW) { const f32x4* xr = (const f32x4*)(X + (size_t)m * DM) + lane;
        f32x4 v[4]; float s = 0.f;
#pragma unroll
        for (int j = 0; j < 4; ++j) { v[j] = xr[64 * j]; s += (v[j].x * v[j].x + v[j].y * v[j].y) + (v[j].z * v[j].z + v[j].w * v[j].w); }
        const float rstd = 1.0f / sqrtf(wave_sum(s) * (1.f / DM) + EPSN);
        u32x2v* o8 = (u32x2v*)(XH + (size_t)m * DM) + lane;
#pragma unroll
        for (int j = 0; j < 4; ++j) { u32x2v w; w.x = cvtpk(v[j].x * rstd, v[j].y * rstd); w.y = cvtpk(v[j].z * rstd, v[j].w * rstd); o8[64 * j] = w; } }
}
__device__ __forceinline__ void cast_rows(const float* X, bf16_t* XB, float* ssp, int nrows, int gw, int NGW, int lane) {
    for (int m = gw; m < nrows; m += NGW) { const f32x4* xr = (const f32x4*)(X + (size_t)m * DM) + lane;
        f32x4 v[4]; float s = 0.f;
#pragma unroll
        for (int j = 0; j < 4; ++j) { v[j] = xr[64 * j]; s += (v[j].x * v[j].x + v[j].y * v[j].y) + (v[j].z * v[j].z + v[j].w * v[j].w); }
        s = wave_sum(s);
        u32x2v* o8 = (u32x2v*)(XB + (size_t)m * DM) + lane;
#pragma unroll
        for (int j = 0; j < 4; ++j) { u32x2v w; w.x = cvtpk(v[j].x, v[j].y); w.y = cvtpk(v[j].z, v[j].w); o8[64 * j] = w; }
        if (lane < 16) ssp[(size_t)m * 16 + lane] = lane == 0 ? s : 0.f; }
}
__device__ __forceinline__ void final_rows(const bf16_t* XB, float* OUT, const float* g, int gw, int NGW, int lane) {
    const f32x4* gr = (const f32x4*)g + lane;
    for (int m = gw; m < MTOK; m += 2 * NGW) {
        const int m1 = m + NGW; const bool has1 = m1 < MTOK;
        const u32x2v* xr0 = (const u32x2v*)(XB + (size_t)m * DM) + lane; const u32x2v* xr1 = (const u32x2v*)(XB + (size_t)(has1 ? m1 : m) * DM) + lane;
        u32x2v w0[4], w1[4];
#pragma unroll
        for (int j = 0; j < 4; ++j) { w0[j] = xr0[64 * j]; w1[j] = xr1[64 * j]; }
        f32x4 v0[4], v1[4]; float s0 = 0.f, s1 = 0.f;
#pragma unroll
        for (int j = 0; j < 4; ++j) {
            v0[j][0] = __builtin_bit_cast(float, w0[j].x << 16); v0[j][1] = __builtin_bit_cast(float, w0[j].x & 0xffff0000u); v0[j][2] = __builtin_bit_cast(float, w0[j].y << 16); v0[j][3] = __builtin_bit_cast(float, w0[j].y & 0xffff0000u);
            v1[j][0] = __builtin_bit_cast(float, w1[j].x << 16); v1[j][1] = __builtin_bit_cast(float, w1[j].x & 0xffff0000u); v1[j][2] = __builtin_bit_cast(float, w1[j].y << 16); v1[j][3] = __builtin_bit_cast(float, w1[j].y & 0xffff0000u);
            s0 += (v0[j].x * v0[j].x + v0[j].y * v0[j].y) + (v0[j].z * v0[j].z + v0[j].w * v0[j].w); s1 += (v1[j].x * v1[j].x + v1[j].y * v1[j].y) + (v1[j].z * v1[j].z + v1[j].w * v1[j].w); }
#pragma unroll
        for (int o = 1; o < 64; o <<= 1) { s0 += __shfl_xor(s0, o); s1 += __shfl_xor(s1, o); }
        const float r0 = 1.0f / sqrtf(s0 * (1.f / DM) + EPSN), r1 = 1.0f / sqrtf(s1 * (1.f / DM) + EPSN);
        f32x4* o0 = (f32x4*)(OUT + (size_t)m * DM) + lane;
#pragma unroll
        for (int j = 0; j < 4; ++j) o0[64 * j] = v0[j] * r0 * gr[64 * j];
        if (has1) { f32x4* o1 = (f32x4*)(OUT + (size_t)m1 * DM) + lane;
#pragma unroll
            for (int j = 0; j < 4; ++j) o1[64 * j] = v1[j] * r1 * gr[64 * j]; }
    }
}
__device__ __forceinline__ float lam_init_of(int l) { return l == 0 ? 0.2f : (l == 1 ? 0.35550906759096926f : (l == 2 ? 0.47071301834358416f : 0.5560582041556405f)); }

constexpr int A_KOFF = 0, A_VOFF = 67584, A_TOFF = 102400, A_WOFF = 119808;
__device__ __forceinline__ int crowc(int r) { return (r & 3) + 8 * (r >> 2); }

template <int D, int DV, bool TAB, bool BITS, int KT>
__device__ __forceinline__ void attn_pass(unsigned char* lds, const bf16_t* Qp, int ldq, const bf16_t* Kp, int ldk, const bf16_t* Vtp, int ldvt,
                                          const float* tabg, const unsigned* bitsp, int q0, int t_lo, int t_hi, int win, float c2, f32x16 (&o)[DV / 32], bool ltab) {
    constexpr int KP = D * 2 + 16, VP = KT * 2 + 8, KBUF = KT * KP, VBUF = DV * VP, DC = D / 8, VC = KT / 8, NKC = KT * DC / 512, NVC = DV * VC / 512, NSUB = KT / 64, NBW = KT / 32;
    constexpr int KOFF = 0, VOFF = 2 * KBUF, TOFF = VOFF + 2 * VBUF, WOFF = TOFF + TABN * 4;
    static_assert(WOFF + 2048 <= LDS_BYTES - 64, "attention LDS map");
    int tid_o = threadIdx.x; asm volatile("" : "+v"(tid_o));
    const int tid = tid_o, lane = tid & 63, wid = __builtin_amdgcn_readfirstlane(tid >> 6), r32 = lane & 31, hi = lane >> 5;
    float* tabL = (float*)(lds + TOFF); float* wsf = (float*)(lds + WOFF) + wid * 64;
    if (TAB && ltab) { for (int i = tid; i < TABN / 4; i += 512) ((f32x4*)tabL)[i] = ((const f32x4*)tabg)[i]; }
    bf16x8 qf[D / 16];
    { const bf16_t* qrow = Qp + (size_t)(32 * wid + r32) * ldq + 8 * hi;
#pragma unroll
      for (int kk = 0; kk < D / 16; ++kk) { const u32x4v raw = *(const u32x4v*)(qrow + kk * 16); u32x4v sc4;
#pragma unroll
          for (int e = 0; e < 4; ++e) { const float lo = __builtin_bit_cast(float, raw[e] << 16) * c2, hh = __builtin_bit_cast(float, raw[e] & 0xffff0000u) * c2; sc4[e] = cvtpk(lo, hh); }
          qf[kk] = __builtin_bit_cast(bf16x8, sc4); } }
#pragma unroll
    for (int dt = 0; dt < DV / 32; ++dt)
#pragma unroll
        for (int r = 0; r < 16; ++r) o[dt][r] = 0.f;
    float mhat = 0.f, l_run = 0.f;
    const int qpos = q0 + 32 * wid + r32, qw_lo = q0 + 32 * wid, qw_hi = qw_lo + 31;
    u32x4v kreg[NKC], vreg[NVC];
#define AT_LOAD(t) do { const int k0_ = (t) * KT; \
        _Pragma("unroll") for (int i = 0; i < NKC; ++i) { const int c = tid + i * 512, key = c / DC, ch = c % DC; kreg[i] = *(const u32x4v*)(Kp + (size_t)(k0_ + key) * ldk + ch * 8); } \
        _Pragma("unroll") for (int i = 0; i < NVC; ++i) { const int c = tid + i * 512, row = c / VC, ch = c % VC; vreg[i] = *(const u32x4v*)(Vtp + (size_t)row * ldvt + k0_ + ch * 8); } } while (0)
#define AT_STORE(buf) do { \
        _Pragma("unroll") for (int i = 0; i < NKC; ++i) { const int c = tid + i * 512, key = c / DC, ch = c % DC; *(u32x4v*)(lds + KOFF + (buf) * KBUF + key * KP + ch * 16) = kreg[i]; } \
        _Pragma("unroll") for (int i = 0; i < NVC; ++i) { const int c = tid + i * 512, row = c / VC, ch = c % VC; unsigned char* d_ = lds + VOFF + (buf) * VBUF + row * VP + ch * 16; \
            *(u32x2v*)d_ = (u32x2v){vreg[i].x, vreg[i].y}; *(u32x2v*)(d_ + 8) = (u32x2v){vreg[i].z, vreg[i].w}; } } while (0)
    AT_LOAD(t_lo); AT_STORE(0);
    unsigned wq[NBW], wn[NBW];
    const unsigned* bprow = BITS ? bitsp + (size_t)(32 * wid + r32) * 128 : nullptr;
#pragma unroll
    for (int i = 0; i < NBW; ++i) { wq[i] = 0xffffffffu; wn[i] = 0xffffffffu; if (BITS) wq[i] = bprow[NBW * t_lo + i]; }
    __syncthreads();
    int cur = 0;
    for (int t = t_lo; t < t_hi; ++t) {
        if (t + 1 < t_hi) { AT_LOAD(t + 1); if (BITS) {
#pragma unroll
            for (int i = 0; i < NBW; ++i) wn[i] = bprow[NBW * (t + 1) + i]; } }
#pragma unroll
        for (int sub = 0; sub < NSUB; ++sub) {
        const int k0 = t * KT + sub * 64;
        bool active = true;
        if (TAB) active = (k0 <= qw_hi) && (k0 + 63 >= qw_lo - win);
        if (active) {
            const unsigned char* Kl = lds + KOFF + cur * KBUF + sub * 64 * KP; const unsigned char* Vl = lds + VOFF + cur * VBUF + sub * 128;
            f32x16 p0, p1;
            unsigned w0 = 0xffffffffu, w1 = 0xffffffffu;
            if (BITS) { w0 = wq[2 * sub] >> (4 * hi); w1 = wq[2 * sub + 1] >> (4 * hi); }
            const float nm = -mhat;
            const int tj = TABN - 1 - TABOFF - qpos + k0 + 4 * hi;
            constexpr int KG = (D > 64) ? 2 : 4;
            if (D == 64) {
                bf16x8 ka[4], kb[4];
                if (TAB) {
#pragma unroll
                    for (int r = 0; r < 16; ++r) p0[r] = tabL[tj + crowc(r)]; }
#pragma unroll
                for (int kk = 0; kk < 4; ++kk) ka[kk] = *(const bf16x8*)(Kl + r32 * KP + (kk * 16 + 8 * hi) * 2);
                if (TAB) {
#pragma unroll
                    for (int r = 0; r < 16; ++r) p1[r] = tabL[tj + 32 + crowc(r)]; }
#pragma unroll
                for (int kk = 0; kk < 4; ++kk) kb[kk] = *(const bf16x8*)(Kl + (32 + r32) * KP + (kk * 16 + 8 * hi) * 2);
                __builtin_amdgcn_sched_barrier(0);
#pragma unroll
                for (int r = 0; r < 16; ++r) { if (TAB) p0[r] -= mhat; else p0[r] = nm; if (BITS) { if (!((w0 >> crowc(r)) & 1u)) p0[r] = NEGV; } }
                __builtin_amdgcn_sched_barrier(0);
#pragma unroll
                for (int kk = 0; kk < 4; ++kk) p0 = __builtin_amdgcn_mfma_f32_32x32x16_bf16(ka[kk], qf[kk], p0, 0, 0, 0);
#pragma unroll
                for (int r = 0; r < 16; ++r) { if (TAB) p1[r] -= mhat; else p1[r] = nm; if (BITS) { if (!((w1 >> crowc(r)) & 1u)) p1[r] = NEGV; } }
                __builtin_amdgcn_sched_barrier(0);
#pragma unroll
                for (int kk = 0; kk < 4; ++kk) p1 = __builtin_amdgcn_mfma_f32_32x32x16_bf16(kb[kk], qf[kk], p1, 0, 0, 0);
                __builtin_amdgcn_sched_barrier(0x1 | 0x2 | 0x100);
            } else {
                if (TAB) {
#pragma unroll
                    for (int r = 0; r < 16; ++r) p0[r] = tabL[tj + crowc(r)];
#pragma unroll
                    for (int r = 0; r < 16; ++r) p1[r] = tabL[tj + 32 + crowc(r)];
                    __builtin_amdgcn_sched_barrier(0);
#pragma unroll
                    for (int r = 0; r < 16; ++r) { p0[r] -= mhat; p1[r] -= mhat; }
                } else {
#pragma unroll
                    for (int r = 0; r < 16; ++r) { p0[r] = nm; p1[r] = nm; }
                }
                if (BITS) {
#pragma unroll
                    for (int r = 0; r < 16; ++r) { const int off = crowc(r); if (!((w0 >> off) & 1u)) p0[r] = NEGV; if (!((w1 >> off) & 1u)) p1[r] = NEGV; } }
#pragma unroll
                for (int k4 = 0; k4 < D / 16; k4 += KG) {
                    bf16x8 ka[KG], kb[KG];
#pragma unroll
                    for (int kk = 0; kk < KG; ++kk) { ka[kk] = *(const bf16x8*)(Kl + r32 * KP + ((k4 + kk) * 16 + 8 * hi) * 2); kb[kk] = *(const bf16x8*)(Kl + (32 + r32) * KP + ((k4 + kk) * 16 + 8 * hi) * 2); }
                    __builtin_amdgcn_sched_barrier(0);
#pragma unroll
                    for (int kk = 0; kk < KG; ++kk) { p0 = __builtin_amdgcn_mfma_f32_32x32x16_bf16(ka[kk], qf[k4 + kk], p0, 0, 0, 0); p1 = __builtin_amdgcn_mfma_f32_32x32x16_bf16(kb[kk], qf[k4 + kk], p1, 0, 0, 0); }
                    __builtin_amdgcn_sched_barrier(0);
                }
            }
            asm volatile("s_nop 15\n\ts_nop 7" : "+v"(p0), "+v"(p1));
            float mx = max3f(p0[0], p1[0], p0[1]), mx2 = max3f(p1[1], p0[2], p1[2]);
#pragma unroll
            for (int r = 3; r < 15; r += 2) { mx = max3f(mx, p0[r], p1[r]); mx2 = max3f(mx2, p0[r + 1], p1[r + 1]); }
            mx = max3f(mx, p0[15], p1[15]); mx = max3f(mx, mx2, mx2);
            mx = swap32_max(mx);
            if (__any(mx > 8.0f)) {
                const float dl = fmaxf(mx, 0.f); mhat += dl;
#pragma unroll
                for (int r = 0; r < 16; ++r) { p0[r] -= dl; p1[r] -= dl; }
                const float alpha = __builtin_amdgcn_exp2f(-dl); l_run *= alpha;
                if (hi == 0) wsf[r32] = alpha;
                __builtin_amdgcn_fence(__ATOMIC_RELEASE, "wavefront"); __builtin_amdgcn_wave_barrier();
#pragma unroll
                for (int j = 0; j < 4; ++j) { const f32x4 a4 = *(const f32x4*)(wsf + 8 * j + 4 * hi);
#pragma unroll
                    for (int dt = 0; dt < DV / 32; ++dt) { o[dt][4 * j + 0] *= a4[0]; o[dt][4 * j + 1] *= a4[1]; o[dt][4 * j + 2] *= a4[2]; o[dt][4 * j + 3] *= a4[3]; } }
                __builtin_amdgcn_fence(__ATOMIC_RELEASE, "wavefront"); __builtin_amdgcn_wave_barrier();
            }
            float rs = 0.f;
            bf16x8 vc[DV / 32];
#define AT_VLOAD(dst, g) do { _Pragma("unroll") for (int dt = 0; dt < DV / 32; ++dt) { const unsigned char* vp = Vl + (dt * 32 + r32) * VP + (16 * (g) + 4 * hi) * 2; \
                const s16x4 lo = *(const s16x4*)vp, hh = *(const s16x4*)(vp + 16); dst[dt] = (bf16x8){lo[0], lo[1], lo[2], lo[3], hh[0], hh[1], hh[2], hh[3]}; } } while (0)
#pragma unroll
            for (int g = 0; g < 4; ++g) {
                AT_VLOAD(vc, g);
                float e[8];
#pragma unroll
                for (int i = 0; i < 8; ++i) { e[i] = __builtin_amdgcn_exp2f(g < 2 ? p0[(g & 1) * 8 + i] : p1[(g & 1) * 8 + i]); rs += e[i]; }
                u32x4v pw; pw.x = cvtpk(e[0], e[1]); pw.y = cvtpk(e[2], e[3]); pw.z = cvtpk(e[4], e[5]); pw.w = cvtpk(e[6], e[7]);
                const bf16x8 pa = __builtin_bit_cast(bf16x8, pw);
                __builtin_amdgcn_sched_barrier(0);
#pragma unroll
                for (int dt = 0; dt < DV / 32; ++dt) o[dt] = __builtin_amdgcn_mfma_f32_32x32x16_bf16(pa, vc[dt], o[dt], 0, 0, 0);
                __builtin_amdgcn_sched_barrier(0x1 | 0x2 | 0x100);
            }
            l_run += rs;
#undef AT_VLOAD
        }
        }
        if (t + 1 < t_hi) AT_STORE(cur ^ 1);
        if (BITS) {
#pragma unroll
            for (int i = 0; i < NBW; ++i) wq[i] = wn[i]; }
        __syncthreads();
        cur ^= 1;
    }
#undef AT_LOAD
#undef AT_STORE
    const float lt = swap32_add(l_run);
    if (hi == 0) wsf[r32] = 1.0f / fmaxf(lt, 1e-30f);
    __builtin_amdgcn_fence(__ATOMIC_RELEASE, "wavefront"); __builtin_amdgcn_wave_barrier();
#pragma unroll
    for (int j = 0; j < 4; ++j) { const f32x4 a4 = *(const f32x4*)(wsf + 8 * j + 4 * hi);
#pragma unroll
        for (int dt = 0; dt < DV / 32; ++dt) { o[dt][4 * j + 0] *= a4[0]; o[dt][4 * j + 1] *= a4[1]; o[dt][4 * j + 2] *= a4[2]; o[dt][4 * j + 3] *= a4[3]; } }
    __builtin_amdgcn_fence(__ATOMIC_RELEASE, "wavefront"); __builtin_amdgcn_wave_barrier();
}
template <int DV>
__device__ __forceinline__ void attn_store(const f32x16 (&o)[DV / 32], bf16_t* Op, int ldo) {
    int tid_o = threadIdx.x; asm volatile("" : "+v"(tid_o));
    const int lane = tid_o & 63, wid = tid_o >> 6, r32 = lane & 31, hi = lane >> 5;
#pragma unroll
    for (int dt = 0; dt < DV / 32; ++dt)
#pragma unroll
        for (int r = 0; r < 16; ++r) { const int row = 32 * wid + crowc(r) + 4 * hi; Op[(size_t)row * ldo + dt * 32 + r32] = (bf16_t)(cvtpk(o[dt][r], 0.f) & 0xffffu); }
}
__device__ __forceinline__ void deal_unit(int it, int& b, int& h, int& qb) { const int bh = it & 63, qs = it >> 6, i = qs >> 2, s = qs & 3; b = bh >> 2; h = bh & 3; qb = (i & 1) ? (4 * i + 3 - s) : (4 * i + s); }

__device__ __forceinline__ void pk_cnt_lt(unsigned& acc, unsigned k2, unsigned mid2, unsigned one2) {
    unsigned t; asm volatile("v_pk_sub_u16 %0, %2, %3 clamp\n\tv_pk_min_u16 %0, %0, %4\n\tv_pk_add_u16 %1, %1, %0" : "=&v"(t), "+v"(acc) : "v"(mid2), "v"(k2), "v"(one2));
}
__device__ __forceinline__ int red32(int v) {
    v += __builtin_amdgcn_mov_dpp(v, 0xB1, 0xf, 0xf, true);
    v += __builtin_amdgcn_mov_dpp(v, 0x4E, 0xf, 0xf, true);
    v += __builtin_amdgcn_mov_dpp(v, 0x141, 0xf, 0xf, true);
    v += __builtin_amdgcn_mov_dpp(v, 0x140, 0xf, 0xf, true);
    v += __builtin_amdgcn_ds_swizzle(v, 0x401F);
    return v;
}
__device__ __forceinline__ unsigned ltu(unsigned a, unsigned b) { unsigned d; asm volatile("v_sub_u32 %0, %1, %2\n\tv_lshrrev_b32 %0, 31, %0" : "=v"(d) : "v"(a), "v"(b)); return d; }
__device__ __forceinline__ unsigned pk_flag_gt(unsigned k2, unsigned T2, unsigned one2) { unsigned t; asm volatile("v_pk_sub_u16 %0, %1, %2 clamp\n\tv_pk_min_u16 %0, %0, %3" : "=&v"(t) : "v"(k2), "v"(T2), "v"(one2)); return t; }
__device__ __forceinline__ int scan32_incl(int x, int lane) {
    x += __builtin_amdgcn_update_dpp(0, x, 0x111, 0xf, 0xf, true);
    x += __builtin_amdgcn_update_dpp(0, x, 0x112, 0xf, 0xf, true);
    x += __builtin_amdgcn_update_dpp(0, x, 0x114, 0xf, 0xf, true);
    x += __builtin_amdgcn_update_dpp(0, x, 0x118, 0xf, 0xf, true);
    const int r15 = __builtin_amdgcn_readlane(x, 15), r47 = __builtin_amdgcn_readlane(x, 47);
    x += (lane & 16) ? ((lane & 32) ? r47 : r15) : 0;
    return x;
}
template <int NCH>
__device__ __forceinline__ void idx_select(const unsigned short* sc, unsigned* bits, size_t tok0, int tid) {
    const int row = tid >> 5, j = tid & 31, lane = tid & 63;
    unsigned kw[4 * NCH];
    { const u32x4v* src = (const u32x4v*)(sc + row * 4096) + j;
#pragma unroll
      for (int i = 0; i < NCH; ++i) { const u32x4v v = src[i * 32]; kw[4 * i] = v.x; kw[4 * i + 1] = v.y; kw[4 * i + 2] = v.z; kw[4 * i + 3] = v.w; } }
    const unsigned one2 = 0x00010001u;
    unsigned lo = 1u, hi_ = 0xFFFFu;
#pragma unroll 1
    for (int it = 0; it < 16; ++it) { const unsigned mid = (lo + hi_ + 1u) >> 1, mid2 = mid | (mid << 16);
        unsigned c2a = 0u, c2b = 0u;
#pragma unroll
        for (int i = 0; i < 4 * NCH; i += 2) { pk_cnt_lt(c2a, kw[i], mid2, one2); pk_cnt_lt(c2b, kw[i + 1], mid2, one2); }
        int cnt = 8 * NCH - (int)((c2a & 0xFFFFu) + (c2a >> 16) + (c2b & 0xFFFFu) + (c2b >> 16));
        cnt = red32(cnt);
        if (cnt >= 256) lo = mid; else hi_ = mid - 1u;
        if (cnt == 256) hi_ = mid;
        if (__all(lo == hi_)) break; }
    const unsigned T = lo, T2 = T | (T << 16);
    unsigned gm[NCH], em[NCH]; int cgt = 0;
#pragma unroll
    for (int i = 0; i < NCH; ++i) { unsigned g8 = 0u, e8 = 0u;
#pragma unroll
        for (int w = 0; w < 4; ++w) { const unsigned g2 = pk_flag_gt(kw[4 * i + w], T2, one2), l2 = pk_flag_gt(T2, kw[4 * i + w], one2), e2 = one2 - g2 - l2;
            g8 |= ((g2 | (g2 >> 15)) & 3u) << (2 * w); e8 |= ((e2 | (e2 >> 15)) & 3u) << (2 * w); }
        gm[i] = g8; em[i] = e8; cgt += __builtin_popcount(g8); }
    const int need = 256 - red32(cgt);
    int carry = 0;
    unsigned char* brow = (unsigned char*)(bits + (tok0 + row) * 128);
#pragma unroll
    for (int i = 0; i < NCH; ++i) { const int ec = __builtin_popcount(em[i]); const int incl = scan32_incl(ec, lane);
        const int quota = need - carry - (incl - ec);
        unsigned se = (quota >= ec) ? em[i] : 0u;
        if (__any(quota > 0 && quota < ec)) { unsigned m = em[i], r = 0u;
#pragma unroll
            for (int t = 0; t < 8; ++t) { const unsigned b = m & (0u - m); if (t < quota) r |= b; m ^= b; }
            if (quota > 0 && quota < ec) se = r; }
        carry += (lane & 32) ? __builtin_amdgcn_readlane(incl, 63) : __builtin_amdgcn_readlane(incl, 31);
        brow[i * 32 + j] = (unsigned char)(gm[i] | se); }
    if (NCH < 16) { unsigned* zr = (unsigned*)(brow + NCH * 32);
#pragma unroll
        for (int i = 0; i < (16 - NCH) * 8; i += 32) if (i + j < (16 - NCH) * 8) zr[i + j] = 0u; }
}

__device__ __forceinline__ void idx_unit(unsigned char* lds, const bf16_t* P, int b, int qb16, unsigned* bits) {
    int tid_o = threadIdx.x; asm volatile("" : "+v"(tid_o));
    const int tid = tid_o, lane = tid & 63, wid = __builtin_amdgcn_readfirstlane(tid >> 6), r32 = lane & 31, hi = lane >> 5;
    unsigned short* sc = (unsigned short*)lds;
    float* wl = (float*)(lds + 131072);
    const int t0 = qb16 * 16; const size_t tokb = (size_t)b * SEQ, tok0 = tokb + t0;
    const int nscan = ((t0 + 16 + 511) >> 9) << 9;
    const int ncomp = ((t0 + 16 + 31) / 32);
    const int nblk = ncomp;
    if (tid < 128) wl[tid] = bf2f(P[(tok0 + (tid >> 3)) * PW + P_IW + (tid & 7)]) * (0.35355339059327373f * 0.125f);
    bf16x8 aq[4][4];
#pragma unroll
    for (int rb = 0; rb < 4; ++rb) { const bf16_t* ap = P + (tok0 + rb * 4 + (r32 >> 3)) * PW + P_IQ + (r32 & 7) * 64 + 8 * hi;
#pragma unroll
        for (int kk = 0; kk < 4; ++kk) aq[rb][kk] = *(const bf16x8*)(ap + kk * 16); }
    __syncthreads();
    f32x4 wreg[16];
#pragma unroll
    for (int q = 0; q < 16; ++q) wreg[q] = *(const f32x4*)(wl + q * 8 + 4 * hi);
    bf16x8 bk[4], bn[4];
    { const bf16_t* kp = P + (tokb + (wid < nblk ? wid : 0) * 32 + r32) * PW + P_IK + 8 * hi;
#pragma unroll
      for (int kk = 0; kk < 4; ++kk) { bk[kk] = *(const bf16x8*)(kp + kk * 16); bn[kk] = bk[kk]; } }
    for (int blk = wid; blk < nblk; blk += 8) {
        const int key = blk * 32 + r32;
        if (blk + 8 < nblk) { const bf16_t* kp = P + (tokb + key + 256) * PW + P_IK + 8 * hi;
#pragma unroll
            for (int kk = 0; kk < 4; ++kk) bn[kk] = *(const bf16x8*)(kp + kk * 16); }
#pragma unroll
        for (int rb = 0; rb < 4; ++rb) {
            f32x16 c;
#pragma unroll
            for (int r = 0; r < 16; ++r) c[r] = 0.f;
#pragma unroll
            for (int kk = 0; kk < 4; ++kk) c = __builtin_amdgcn_mfma_f32_32x32x16_bf16(aq[rb][kk], bk[kk], c, 0, 0, 0);
            asm volatile("s_nop 15\n\ts_nop 7" : "+v"(c));
            float tq0, tq1, tq2, tq3;
#define IDX_TOT(j) ({ const f32x4 w4 = wreg[rb * 4 + (j)]; \
                const float part = w4[0] * reluf(c[4 * (j)]) + w4[1] * reluf(c[4 * (j) + 1]) + w4[2] * reluf(c[4 * (j) + 2]) + w4[3] * reluf(c[4 * (j) + 3]); swap32_add(part); })
            tq0 = IDX_TOT(0); tq1 = IDX_TOT(1); tq2 = IDX_TOT(2); tq3 = IDX_TOT(3);
#undef IDX_TOT
            const float ts0 = hi ? tq2 : tq0, ts1 = hi ? tq3 : tq1;
#pragma unroll
            for (int jj = 0; jj < 2; ++jj) { const float tv = jj ? ts1 : ts0; const int q = rb * 4 + 2 * hi + jj;
                unsigned short kv = 0;
                if (key <= t0 + q) { const _Float16 hv = (_Float16)tv; const unsigned short hb = __builtin_bit_cast(unsigned short, hv); kv = (hb & 0x8000u) ? (unsigned short)~hb : (unsigned short)(hb | 0x8000u); }
                sc[q * 4096 + key] = kv; }
        }
#pragma unroll
        for (int kk = 0; kk < 4; ++kk) bk[kk] = bn[kk];
    }
    { const int z0 = ncomp * 32, zn = (nscan - z0) >> 3;
      for (int e = tid; e < zn * 16; e += 512) { const int r = e / zn, c = e - r * zn; *(u32x4v*)(sc + r * 4096 + z0 + 8 * c) = (u32x4v){0u, 0u, 0u, 0u}; } }
    __syncthreads();
    switch (nscan >> 9) {
        case 1: idx_select<2>(sc, bits, tok0, tid); break;
        case 2: idx_select<4>(sc, bits, tok0, tid); break;
        case 3: idx_select<6>(sc, bits, tok0, tid); break;
        case 4: idx_select<8>(sc, bits, tok0, tid); break;
        case 5: idx_select<10>(sc, bits, tok0, tid); break;
        case 6: idx_select<12>(sc, bits, tok0, tid); break;
        case 7: idx_select<14>(sc, bits, tok0, tid); break;
        default: idx_select<16>(sc, bits, tok0, tid); break;
    }
    __syncthreads();
}

struct MixCtx { const bf16_t* P; const bf16_t* VT; bf16_t* MIX; const float* tabs; const unsigned* bits; const float* subln_base; const float* lamv; int l; float* stash; int nthr; };

__device__ __forceinline__ void unitA(unsigned char* lds, const MixCtx& c, int b, int h, int qb, bool ltab) {
    const int q0 = qb * 256; const size_t tokb = (size_t)b * SEQ; const int t_hi = (q0 + 256) / 128;
    const float c2 = 0.125f * LOG2E;
    f32x16 oa[4], ob[4];
    attn_pass<64, 128, true, false, 128>(lds, c.P + (tokb + q0) * PW + P_AQ + h * 128, PW, c.P + tokb * PW + P_AK + h * 128, PW, c.VT + (size_t)(V_A + h * 128) * MTOK + tokb, MTOK,
                                    c.tabs + h * TABN, nullptr, q0, 0, t_hi, 1 << 24, c2, oa, ltab);
    { int tid_s = threadIdx.x; asm volatile("" : "+v"(tid_s)); float* st = c.stash + (size_t)blockIdx.x * 512 + tid_s; asm volatile("" : "+v"(st));
#pragma unroll
      for (int dt = 0; dt < 4; ++dt)
#pragma unroll
          for (int r = 0; r < 16; ++r) st[(size_t)(dt * 16 + r) * c.nthr] = oa[dt][r];
      asm volatile("" ::: "memory"); }
    attn_pass<64, 128, true, false, 128>(lds, c.P + (tokb + q0) * PW + P_AQ + h * 128 + 64, PW, c.P + tokb * PW + P_AK + h * 128 + 64, PW, c.VT + (size_t)(V_A + h * 128) * MTOK + tokb, MTOK,
                                    c.tabs + h * TABN, nullptr, q0, 0, t_hi, 1 << 24, c2, ob, false);
    int l_o = c.l; asm volatile("" : "+s"(l_o));
    const float lam = c.lamv[l_o], lam_init = lam_init_of(l_o); const float* subln = c.subln_base + l_o * 128;
    int tid_o = threadIdx.x; asm volatile("" : "+v"(tid_o));
    const int lane = tid_o & 63, r32 = lane & 31;
    { const float* st = c.stash + (size_t)blockIdx.x * 512 + tid_o; asm volatile("" : "+v"(st) :: "memory");
#pragma unroll
      for (int dt = 0; dt < 4; ++dt)
#pragma unroll
          for (int r = 0; r < 16; ++r) oa[dt][r] = st[(size_t)(dt * 16 + r) * c.nthr]; }
    float ss[16];
#pragma unroll
    for (int r = 0; r < 16; ++r) { float s = 0.f;
#pragma unroll
        for (int dt = 0; dt < 4; ++dt) { const float v = oa[dt][r] - lam * ob[dt][r]; oa[dt][r] = v; s += v * v; }
        ss[r] = s; }
#pragma unroll
    for (int r = 0; r < 16; ++r) {
#pragma unroll
        for (int o = 1; o < 32; o <<= 1) ss[r] += __shfl_xor(ss[r], o);
        ss[r] = (1.0f - lam_init) / sqrtf(ss[r] * (1.f / 128.f) + EPSN); }
#pragma unroll
    for (int dt = 0; dt < 4; ++dt) { const float g = subln[dt * 32 + r32];
#pragma unroll
        for (int r = 0; r < 16; ++r) oa[dt][r] = oa[dt][r] * ss[r] * g; }
    attn_store<128>(oa, c.MIX + (tokb + q0) * DM + h * 128, DM);
}
__device__ __forceinline__ void unitB(unsigned char* lds, const MixCtx& c, int b, int h, int qb, bool ltab) {
    const int q0 = qb * 256; const size_t tokb = (size_t)b * SEQ; const int t_hi = (q0 + 256) / 128; int t_lo = (q0 - 2048) / 128; if (t_lo < 0) t_lo = 0;
    f32x16 o[2];
    attn_pass<64, 64, true, false, 128>(lds, c.P + (tokb + q0) * PW + P_BQ + h * 64, PW, c.P + tokb * PW + P_BK + h * 64, PW, c.VT + (size_t)(V_B + h * 64) * MTOK + tokb, MTOK,
                                   c.tabs + (4 + h) * TABN, nullptr, q0, t_lo, t_hi, 2048, 0.125f * LOG2E, o, ltab);
    attn_store<64>(o, c.MIX + (tokb + q0) * DM + 512 + h * 64, DM);
}
__device__ __forceinline__ void unitC(unsigned char* lds, const MixCtx& c, int b, int h, int qb, bool ltab) {
    const int q0 = qb * 256; const size_t tokb = (size_t)b * SEQ; const int t_hi = (q0 + 256) / 128;
    f32x16 o[2];
    attn_pass<64, 64, true, true, 128>(lds, c.P + (tokb + q0) * PW + P_CQ + h * 64, PW, c.P + tokb * PW + P_CK + h * 64, PW, c.VT + (size_t)(V_C + h * 64) * MTOK + tokb, MTOK,
                                  c.tabs + (8 + h) * TABN, c.bits + (tokb + q0) * 128, q0, 0, t_hi, 1 << 24, 0.125f * LOG2E, o, ltab);
    attn_store<64>(o, c.MIX + (tokb + q0) * DM + 768 + h * 64, DM);
}
__device__ __forceinline__ void unitM(unsigned char* lds, const bf16_t* QM, const bf16_t* MK, const bf16_t* MVT, bf16_t* MIX, int l, int b, int h, int half, int qb) {
    const int q0 = qb * 256; const size_t tokb = (size_t)b * SEQ;
    f32x16 o[4];
    attn_pass<256, 128, false, false, 64>(lds, QM + (tokb + q0) * DM + h * 256, DM, MK + (size_t)(b * MEMLEN) * 4096 + l * 1024 + h * 256, 4096,
                                      MVT + (size_t)(l * 1024 + h * 256 + half * 128) * MMEM + b * MEMLEN, MMEM, nullptr, nullptr, q0, 0, MEMLEN / 64, 1 << 24, 0.0625f * LOG2E, o, false);
    attn_store<128>(o, MIX + (tokb + q0) * DM + h * 256 + half * 128, DM);
}

__device__ __forceinline__ void conv_fix_phase(const bf16_t* Fb, const bf16_t* Hb, bf16_t* G, const float* cw, const float* cb, int gtid, int nthr) {
    constexpr int CG = FF / 8, NSEG = MTOK / 64;
    const int nitems = NSEG * 2 * CG;
    for (int it = gtid; it < nitems; it += nthr) { const int cgi = it % CG, rest = it / CG, i = rest & 1, sg = rest >> 1, c0 = cgi * 8;
        const bool has = ((sg * 64) & (SEQ - 1)) != 0;
        const u32x4v z = (u32x4v){0u, 0u, 0u, 0u};
        const u32x4v u0g = *(const u32x4v*)(Fb + ((size_t)sg * 2 + i) * FF2 + c0), u0v = *(const u32x4v*)(Fb + ((size_t)sg * 2 + i) * FF2 + FF + c0);
        u32x4v p1g = z, p1v = z, p2g = z, p2v = z;
        if (i == 0) { if (has) { p1g = *(const u32x4v*)(Hb + ((size_t)(sg - 1) * 2 + 1) * FF2 + c0); p1v = *(const u32x4v*)(Hb + ((size_t)(sg - 1) * 2 + 1) * FF2 + FF + c0);
                                 p2g = *(const u32x4v*)(Hb + ((size_t)(sg - 1) * 2) * FF2 + c0); p2v = *(const u32x4v*)(Hb + ((size_t)(sg - 1) * 2) * FF2 + FF + c0); } }
        else { p1g = *(const u32x4v*)(Fb + ((size_t)sg * 2) * FF2 + c0); p1v = *(const u32x4v*)(Fb + ((size_t)sg * 2) * FF2 + FF + c0);
               if (has) { p2g = *(const u32x4v*)(Hb + ((size_t)(sg - 1) * 2 + 1) * FF2 + c0); p2v = *(const u32x4v*)(Hb + ((size_t)(sg - 1) * 2 + 1) * FF2 + FF + c0); } }
        float og[8];
#pragma unroll
        for (int e = 0; e < 8; ++e) { const int w = e >> 1, sh = (e & 1) * 16;
            const float a2 = __builtin_bit_cast(float, ((p2g[w] >> sh) & 0xffffu) << 16), a1 = __builtin_bit_cast(float, ((p1g[w] >> sh) & 0xffffu) << 16), a0 = __builtin_bit_cast(float, ((u0g[w] >> sh) & 0xffffu) << 16);
            const float b2 = __builtin_bit_cast(float, ((p2v[w] >> sh) & 0xffffu) << 16), b1 = __builtin_bit_cast(float, ((p1v[w] >> sh) & 0xffffu) << 16), b0 = __builtin_bit_cast(float, ((u0v[w] >> sh) & 0xffffu) << 16);
            const float cgate = cb[c0 + e] + cw[c0 + e] * a2 + cw[FF2 + c0 + e] * a1 + cw[2 * FF2 + c0 + e] * a0;
            const float cval = cb[FF + c0 + e] + cw[FF + c0 + e] * b2 + cw[FF2 + FF + c0 + e] * b1 + cw[2 * FF2 + FF + c0 + e] * b0;
            og[e] = cgate / (1.0f + __expf(-cgate)) * cval; }
        u32x4v w; w.x = cvtpk(og[0], og[1]); w.y = cvtpk(og[2], og[3]); w.z = cvtpk(og[4], og[5]); w.w = cvtpk(og[6], og[7]);
        *(u32x4v*)(G + ((size_t)sg * 64 + i) * FF + c0) = w; }
}

#define RLX_AGENT __ATOMIC_RELAXED, __HIP_MEMORY_SCOPE_AGENT
struct XcdBarrier { unsigned* bar; unsigned x; volatile LAS unsigned* st; };
#define XB_TMO      128
#define XB_XCNT(j)  (256  + 64 * (j))
#define XB_XSUB(j)  (1280 + 64 * (j))
#define XB_XGEN(j)  (2304 + 64 * (j))
#define XB_TOP      3328
#define XB_TOPGEN   3392
#define XCD_BAR_WORDS 3456
#define XB_SPIN_CAP (1u << 18)

__device__ __forceinline__ unsigned xb_ld(unsigned* p)              { return __hip_atomic_load(p, __ATOMIC_RELAXED, __HIP_MEMORY_SCOPE_AGENT); }
__device__ __forceinline__ unsigned xb_add(unsigned* p, unsigned v) { return __hip_atomic_fetch_add(p, v, __ATOMIC_RELAXED, __HIP_MEMORY_SCOPE_AGENT); }
__device__ __forceinline__ unsigned xb_xcc_id() { return (unsigned)__builtin_amdgcn_s_getreg((3 << 11) | 20) & 0xFu; }
#define XB_SPIN(cond, bar) do { unsigned _sp = 0; while (cond) { __builtin_amdgcn_s_sleep(1); \
    if ((++_sp & 255u) == 0u) { if (xb_ld(&(bar)[XB_TMO])) break; if (_sp > XB_SPIN_CAP) { atomicAdd(&(bar)[XB_TMO], 1u); break; } } } } while (0)

__device__ __forceinline__ XcdBarrier xcd_barrier_post(unsigned* bar, volatile LAS unsigned* st) {
    XcdBarrier b; b.bar = bar; b.x = xb_xcc_id(); b.st = st;
    if (threadIdx.x == 0) (void)xb_add(&bar[XB_XCNT(b.x)], 1u);
    return b;
}
__device__ __forceinline__ void xcd_barrier_complete(unsigned* bar, unsigned x, unsigned& nloc, unsigned& nx) {
    const unsigned G = gridDim.x * gridDim.y * gridDim.z;
    unsigned sum, cnt, mine, sp = 0u;
    for (;;) {
        sum = 0u; cnt = 0u; mine = 0u;
#pragma unroll
        for (unsigned j = 0; j < 16; ++j) { const unsigned c = xb_ld(&bar[XB_XCNT(j)]); sum += c; cnt += (c > 0u) ? 1u : 0u; mine = (j == x) ? c : mine; }
        if (sum == G) break;
        __builtin_amdgcn_s_sleep(1);
        if ((++sp & 255u) == 0u) { if (xb_ld(&bar[XB_TMO])) break; if (sp > XB_SPIN_CAP) { atomicAdd(&bar[XB_TMO], 1u); break; } }
    }
    nloc = mine > 0u ? mine : 1u; nx = cnt > 0u ? cnt : 1u;
}

__device__ __forceinline__ void xcd_barrier(const XcdBarrier& b) {
    asm volatile("s_waitcnt vmcnt(0)" ::: "memory");
    __syncthreads();
    if (threadIdx.x == 0) {
        unsigned* bar = b.bar;
        __builtin_amdgcn_s_waitcnt(0);
        unsigned nloc = b.st[0], nx = b.st[1];
        if (nloc == 0u) { xcd_barrier_complete(bar, b.x, nloc, nx); b.st[0] = nloc; b.st[1] = nx; }
        const unsigned old = xb_add(&bar[XB_XSUB(b.x)], 1u);
        const unsigned gen = old / nloc;
        if (old + 1u == (gen + 1u) * nloc) {
            __builtin_amdgcn_fence(__ATOMIC_RELEASE, "agent");
            asm volatile("s_waitcnt vmcnt(0)" ::: "memory");
            const unsigned og = xb_add(&bar[XB_TOP], 1u);
            const unsigned tg = og / nx;
            if (og + 1u == (tg + 1u) * nx) xb_add(&bar[XB_TOPGEN], 1u);
            else XB_SPIN(xb_ld(&bar[XB_TOPGEN]) == tg, bar);
            __builtin_amdgcn_fence(__ATOMIC_ACQUIRE, "agent");
            xb_add(&bar[XB_XGEN(b.x)], 1u);
            asm volatile("s_waitcnt vmcnt(0)" ::: "memory");
        } else {
            XB_SPIN(xb_ld(&bar[XB_XGEN(b.x)]) == gen, bar);
            __builtin_amdgcn_fence(__ATOMIC_ACQUIRE, "agent");
            asm volatile("s_waitcnt vmcnt(0)" ::: "memory");
        }
    }
    __syncthreads();
}

template <class Epi>
__device__ __forceinline__ void run_gemm(LAS unsigned char* ldsl, const bf16_t* A, const bf16_t* Bt, int M, int N, int K, const Epi& E) {
    pg8::Gemm g{A, Bt, M, N, K}; pg8::StaticOrder S; S.init(M, N, (int)gridDim.x, (int)blockIdx.x);
    pg8::gemm_phase<Epi, pg8::StaticOrder, true, true>(ldsl, g, S, E);
}

struct Args { const float* in[22]; float* out; unsigned char* ws; };

__global__ void __launch_bounds__(512, 2) fwd_kernel(Args a) {
    extern __shared__ __attribute__((aligned(16))) unsigned char lds[];
    cg::grid_group grid = cg::this_grid();
    LAS unsigned char* ldsl = (LAS unsigned char*)lds;
    const int G = gridDim.x, cb_ = blockIdx.x, NGW = G * 8, NTHR = G * 512;
    { volatile LAS unsigned* stw = (volatile LAS unsigned*)(ldsl + LDS_BYTES - 64); if (threadIdx.x < 16) stw[threadIdx.x] = 0u; }
    __syncthreads();
    (void)xcd_barrier_post((unsigned*)(a.ws + WS_BAR), (volatile LAS unsigned*)(ldsl + LDS_BYTES - 64));
#define GSYNC() do { XcdBarrier b_; b_.bar = (unsigned*)(a.ws + WS_BAR); b_.x = xb_xcc_id(); b_.st = (volatile LAS unsigned*)(ldsl + LDS_BYTES - 64); xcd_barrier(b_); } while (0)
#define FRESH_TID() ({ int t_ = threadIdx.x; asm volatile("" : "+v"(t_)); t_; })
#define NORM_ROWS(src, dst, nrows) do { const int t_ = FRESH_TID(); norm_rows(src, dst, nrows, cb_ * 8 + (t_ >> 6), NGW, t_ & 63); } while (0)
    unsigned char* ws = a.ws;
    const float* x_in = a.in[0]; float* X = a.out;
    float* lamv = (float*)(ws + WS_LAM); float* tabs = (float*)(ws + WS_TAB);
    bf16_t* WT = (bf16_t*)(ws + WS_WT);
    bf16_t* XH = (bf16_t*)(ws + WS_XH); bf16_t* MIX = (bf16_t*)(ws + WS_MIX); bf16_t* P = (bf16_t*)(ws + WS_P); bf16_t* VT = (bf16_t*)(ws + WS_VT);
    unsigned* BITS = (unsigned*)(ws + WS_BITS); bf16_t* MEMK = (bf16_t*)(ws + WS_MEMK); bf16_t* MEMVT = (bf16_t*)(ws + WS_MEMVT); bf16_t* MEMH = (bf16_t*)(ws + WS_MEMH);
    float* SS0 = (float*)(ws + WS_SS); float* SS1 = SS0 + (size_t)MTOK * 16; float* SS2 = SS1 + (size_t)MTOK * 16;
    bf16_t* GB = (bf16_t*)(ws + WS_G); bf16_t* FB = (bf16_t*)(ws + WS_FB); bf16_t* HB = (bf16_t*)(ws + WS_HB); bf16_t* QM = (bf16_t*)(ws + WS_QM);
    bf16_t* wt_in = (bf16_t*)((unsigned char*)WT + WT_IN); bf16_t* wt_out = (bf16_t*)((unsigned char*)WT + WT_OUT); bf16_t* wt_mq = (bf16_t*)((unsigned char*)WT + WT_MQ);
    bf16_t* wt_mo = (bf16_t*)((unsigned char*)WT + WT_MO); bf16_t* wt_mkv = (bf16_t*)((unsigned char*)WT + WT_MKV); bf16_t* wt_up = (bf16_t*)((unsigned char*)WT + WT_UP); bf16_t* wt_dn = (bf16_t*)((unsigned char*)WT + WT_DN);

    {
        const int tid = FRESH_TID(), lane = tid & 63, wave = __builtin_amdgcn_readfirstlane(tid >> 6), gw = cb_ * 8 + wave, gtid = cb_ * 512 + tid;
        float* scr = (float*)(lds + wave * 8448);
#pragma unroll 1
        for (int it = gw; it < NLAYER * 8704; it += NGW) { const int l = it / 8704; int r = it - l * 8704;
            if (r < 1920) { conv_one(a.in[4] + (size_t)l * DM * NIN, DM, NIN, 0, NIN, a.in[3] + l * DM, wt_in + (size_t)l * NINP * DM, NINP, 1, r, scr, lane); continue; } r -= 1920;
            if (r < 512) { conv_one(a.in[10] + (size_t)l * DM * DM, DM, DM, 0, DM, nullptr, wt_out + (size_t)l * DM * DM, DM, 0, r, scr, lane); continue; } r -= 512;
            if (r < 512) { conv_one(a.in[13] + (size_t)l * DM * DM, DM, DM, 0, DM, a.in[11] + l * DM, wt_mq + (size_t)l * DM * DM, DM, 0, r, scr, lane); continue; } r -= 512;
            if (r < 512) { conv_one(a.in[15] + (size_t)l * DM * DM, DM, DM, 0, DM, nullptr, wt_mo + (size_t)l * DM * DM, DM, 0, r, scr, lane); continue; } r -= 512;
            if (r < 512) { conv_one(a.in[14] + (size_t)l * DM * 2048, DM, 2048, 0, 1024, a.in[12] + l * DM, wt_mkv + (size_t)(l * 1024) * DM, 1024, 0, r, scr, lane); continue; } r -= 512;
            if (r < 512) { conv_one(a.in[14] + (size_t)l * DM * 2048, DM, 2048, 1024, 1024, a.in[12] + l * DM, wt_mkv + (size_t)(4096 + l * 1024) * DM, 1024, 0, r, scr, lane); continue; } r -= 512;
            if (r < 2816) { conv_one(a.in[17] + (size_t)l * DM * FF2, DM, FF2, 0, FF2, a.in[16] + l * DM, wt_up + (size_t)l * FF2 * DM, FF2, 2, r, scr, lane); continue; } r -= 2816;
            conv_one(a.in[20] + (size_t)l * FF * DM, FF, DM, 0, DM, nullptr, wt_dn + (size_t)l * DM * FF, DM, 0, r, scr, lane);
        }
        for (int idx = gtid; idx < 12 * TABN; idx += NTHR) { const int h = idx / TABN, dist = (TABN - 1 - idx % TABN) - TABOFF; float v = NEGV;
            if (dist >= 0) { int bucket = dist;
                if (dist >= 16) { const float nf = (float)dist; const float t = logf(nf / 16.0f) / 4.852030263919617f * 16.0f; int lg = 16 + (int)t; bucket = lg < 31 ? lg : 31; }
                const float bias = a.in[2][bucket * 12 + h];
                if (h >= 4 && h < 8) { const int mult = (dist <= 128 ? 1 : 0) + (((dist & 3) == 0 && dist <= 512) ? 1 : 0) + (((dist & 15) == 0 && dist <= 2048) ? 1 : 0);
                    if (mult > 0) v = (bias + logf((float)mult)) * LOG2E; }
                else v = bias * LOG2E; }
            tabs[idx] = v; }
        if (cb_ == 0 && wave < NLAYER) { const int l = wave;
            const float s1 = wave_sum(a.in[5][l * 64 + lane] * a.in[6][l * 64 + lane]), s2 = wave_sum(a.in[7][l * 64 + lane] * a.in[8][l * 64 + lane]);
            if (lane == 0) lamv[l] = expf(s1) - expf(s2) + lam_init_of(l); }
        norm_rows(a.in[1], MEMH, MMEM, gw, NGW, lane);
        cast_rows(x_in, XH, (float*)(ws + WS_SS), MTOK, gw, NGW, lane);
    }
    grid.sync();
    { pg8::EpiStore E{MEMK, 4096, 0, MEMVT, MMEM, 16, 32, 4096, nullptr}; run_gemm(ldsl, MEMH, wt_mkv, MMEM, 8192, DM, E); }

#pragma unroll 1
    for (int l = 0; l < NLAYER; ++l) {
        { pg8::EpiStore E{P, PW, 1024, VT, MTOK, 0, 4, 0, SS0}; run_gemm(ldsl, XH, wt_in + (size_t)l * NINP * DM, MTOK, NINP, DM, E); }
        GSYNC();
        MixCtx mc{P, VT, MIX, tabs, BITS, a.in[9], lamv, l, (float*)(ws + WS_STASH), NTHR};
        for (int it = cb_; it < 4096; it += G) idx_unit(lds, P, it & 15, it >> 4, BITS);
        { int ph = -1; for (int it = cb_; it < 1024; it += G) { int b, h, qb; deal_unit(it, b, h, qb); unitA(lds, mc, b, h, qb, h != ph); ph = h; } }
        { int ph = -1; for (int it = cb_; it < 1024; it += G) { int b, h, qb; deal_unit(it, b, h, qb); unitB(lds, mc, b, h, qb, h != ph); ph = h; } }
        GSYNC();
        { int ph = -1; for (int it = cb_; it < 1024; it += G) { int b, h, qb; deal_unit(it, b, h, qb); unitC(lds, mc, b, h, qb, h != ph); ph = h; } }
        GSYNC();
        { pg8::EpiResid E{XH, DM, SS1}; run_gemm(ldsl, MIX, wt_out + (size_t)l * DM * DM, MTOK, DM, DM, E); }
        GSYNC();
        { pg8::EpiStore E{QM, DM, 0, nullptr, 0, 0, 0, 0, SS1}; run_gemm(ldsl, XH, wt_mq + (size_t)l * DM * DM, MTOK, DM, DM, E); }
        GSYNC();
        for (int it = cb_; it < 2048; it += G) { const int xcd_ = it & 7, jj_ = ((it >> 3) & 31) * 8 + (it >> 8); const int qb = jj_ & 15, rest = xcd_ * 16 + (jj_ >> 4);     unitM(lds, QM, MEMK, MEMVT, MIX, l, rest >> 3, (rest >> 1) & 3, rest & 1, qb); }
        GSYNC();
        { pg8::EpiResid E{XH, DM, SS2}; run_gemm(ldsl, MIX, wt_mo + (size_t)l * DM * DM, MTOK, DM, DM, E); }
        GSYNC();
        { pg8::EpiConv E{GB, FB, HB, a.in[18] + (size_t)l * 3 * FF2, a.in[19] + (size_t)l * FF2, SS2}; run_gemm(ldsl, XH, wt_up + (size_t)l * FF2 * DM, MTOK, FF2, DM, E); }
        GSYNC();
        { const int t_ = FRESH_TID(); conv_fix_phase(FB, HB, GB, a.in[18] + (size_t)l * 3 * FF2, a.in[19] + (size_t)l * FF2, cb_ * 512 + t_, NTHR); }
        GSYNC();
        { pg8::EpiResid E{XH, DM, SS0}; run_gemm(ldsl, GB, wt_dn + (size_t)l * DM * FF, MTOK, DM, FF, E); }
        GSYNC();
    }
    { const int t_ = FRESH_TID(); final_rows(XH, X, a.in[21], cb_ * 8 + (t_ >> 6), NGW, t_ & 63); }
}

extern "C" void kernel_launch(void* const* d_in, const int* in_sizes, int n_in, void* d_out, int out_size, void* d_ws, size_t ws_size, hipStream_t stream) {
    static int grid_blocks = 0;
    if (grid_blocks == 0) {
        if (n_in != 22 || out_size != MTOK * DM || ws_size < WS_END) { fprintf(stderr, "kernel_launch: unexpected shapes (n_in %d out %d ws %zu)\n", n_in, out_size, ws_size); grid_blocks = -1; return; }
        int dev = 0, cus = 0, per_cu = 0;
        hipGetDevice(&dev);
        hipDeviceGetAttribute(&cus, hipDeviceAttributeMultiprocessorCount, dev);
        if (hipFuncSetAttribute((const void*)fwd_kernel, hipFuncAttributeMaxDynamicSharedMemorySize, LDS_BYTES) != hipSuccess) { fprintf(stderr, "kernel_launch: hipFuncSetAttribute failed\n"); }
        if (hipOccupancyMaxActiveBlocksPerMultiprocessor(&per_cu, (const void*)fwd_kernel, 512, LDS_BYTES) != hipSuccess || per_cu < 1) { fprintf(stderr, "kernel_launch: occupancy query %d\n", per_cu); per_cu = 1; }
        (void)hipGetLastError();
        grid_blocks = cus * per_cu;
    }
    if (grid_blocks < 0) return;
    if (hipMemsetAsync((char*)d_ws + WS_BAR, 0, WS_BAR_BYTES, stream) != hipSuccess) { fprintf(stderr, "kernel_launch: memset failed\n"); return; }
    Args a{};
    for (int i = 0; i < 22; ++i) a.in[i] = (const float*)d_in[i];
    a.out = (float*)d_out; a.ws = (unsigned char*)d_ws;
    void* args[] = {&a};
    hipError_t e = hipLaunchCooperativeKernel((const void*)fwd_kernel, dim3(grid_blocks), dim3(512), args, LDS_BYTES, stream);
    if (e != hipSuccess) fprintf(stderr, "kernel_launch: cooperative launch failed: %s (grid %d)\n", hipGetErrorString(e), grid_blocks);
}
```

```cpp
#include <hip/hip_runtime.h>
#include <hip/hip_cooperative_groups.h>
#include <cstdio>
#include <cstdint>
namespace cg = cooperative_groups;

namespace pg8 {
#define PG8_LAS __attribute__((address_space(3)))
typedef unsigned short bf16_t;
typedef short bf16x8 __attribute__((ext_vector_type(8)));
typedef float f32x4 __attribute__((ext_vector_type(4)));
typedef unsigned u32x4 __attribute__((ext_vector_type(4)));
constexpr int BM = 256, BK = 64, HALF = 128, HTB = HALF * BK * 2  , STAGE_BYTES = 8 * HTB, NXCD = 8, WGM = 8;

__host__ __device__ __forceinline__ int lds_byte(int r, int c) { const int st = (r >> 4) * 2 + (c >> 5), rr = r & 15, cc = c & 31, ob = rr * 64 + cc * 2; return st * 1024 + (ob ^ (((ob >> 9) & 1) << 5)); }
__host__ __device__ __forceinline__ void stage_rc(int b, int& R, int& C) { const int st = b / 1024, sb = b % 1024, swz = sb ^ (((sb >> 9) & 1) << 5); R = (st >> 1) * 16 + swz / 64; C = (st & 1) * 32 + (swz % 64) / 2; }
__host__ __device__ __forceinline__ int perm32(int rho) { const int n = rho >> 4, i = rho & 15; return 8 * (i >> 2) + 4 * n + (i & 3); }

struct Unit { int pm, pn; };
struct Gemm { const bf16_t* A; const bf16_t* Bt; int M, N, K; };

struct StaticOrder {
    int nM, nN, nwg, G, c;
    __host__ __device__ void init(int M, int N, int G_, int c_) { nM = M / BM; nN = N / BM; nwg = nM * nN; G = G_; c = c_; }
    __host__ __device__ bool next(int i, Unit& u) const {
        const long L = (long)i * G + c; if (L >= nwg) return false;
        int wgid = (int)L; { const int q = nwg / NXCD, r = nwg % NXCD, xcd = wgid % NXCD, off = wgid / NXCD; wgid = (xcd < r ? xcd * (q + 1) : r * (q + 1) + (xcd - r) * q) + off; }
        const int nig = WGM * nN, gid = wgid / nig, fm = gid * WGM, gsz = (nM - fm) < WGM ? (nM - fm) : WGM;
        u.pm = fm + ((wgid % nig) % gsz); u.pn = (wgid % nig) / gsz; return true;
    }
    __device__ __forceinline__ void a_ready(const Unit&) const {}
    __device__ __forceinline__ void done(const Unit&) const {}
};

__device__ __forceinline__ unsigned cvt_pk_bf16(float lo, float hi) { unsigned r; asm volatile("v_cvt_pk_bf16_f32 %0, %1, %2" : "=v"(r) : "v"(lo), "v"(hi)); return r; }
__device__ __forceinline__ void load_row_scales(const float* ssp, int row0, int fq, float (&rs)[2][4]) {
    f32x4 part[2][4];
    const float* sp = ssp + (size_t)row0 * 16 + 4 * fq;
#pragma unroll
    for (int ai = 0; ai < 2; ++ai)
#pragma unroll
        for (int m = 0; m < 4; ++m) part[ai][m] = *(const f32x4*)(sp + (size_t)(ai * HALF + m * 16) * 16);
#pragma unroll
    for (int ai = 0; ai < 2; ++ai)
#pragma unroll
        for (int m = 0; m < 4; ++m) { float t = (part[ai][m][0] + part[ai][m][1]) + (part[ai][m][2] + part[ai][m][3]);
            t += __shfl_xor(t, 16); t += __shfl_xor(t, 32);
            rs[ai][m] = 1.0f / sqrtf(t * (1.0f / 1024.0f) + 1e-6f); }
}
struct EpiStore {
    static constexpr bool PERM = true, AFTER_DRAIN = false;
    bf16_t* R; int ldr; int r_col0; bf16_t* T; int ldt; int t_lo, t_hi, t_col0; const float* ssp;
    __device__ __forceinline__ float row_rs(const float* sp) const {
        const f32x4 a = *(const f32x4*)sp, b = *(const f32x4*)(sp + 4), c = *(const f32x4*)(sp + 8), d = *(const f32x4*)(sp + 12);
        const float tot = ((a[0] + a[1]) + (a[2] + a[3])) + ((b[0] + b[1]) + (b[2] + b[3])) + ((c[0] + c[1]) + (c[2] + c[3])) + ((d[0] + d[1]) + (d[2] + d[3]));
        return 1.0f / sqrtf(tot * (1.0f / 1024.0f) + 1e-6f);
    }
    __device__ __forceinline__ void operator()(f32x4 (&acc)[2][2][4][2], const Unit& u, int wr, int wc, int fr, int fq) const {
        const int row0 = u.pm * BM + wr * 64 + fr;
        const int colt = u.pn * BM + wc * 32 + 8 * fq;
        if (u.pn >= t_lo && u.pn < t_hi) {
            if (ssp) { float rs[2][4]; load_row_scales(ssp, row0, fq, rs);
#pragma unroll
                for (int ai = 0; ai < 2; ++ai)
#pragma unroll
                    for (int m = 0; m < 4; ++m)
#pragma unroll
                        for (int bj = 0; bj < 2; ++bj)
#pragma unroll
                            for (int n = 0; n < 2; ++n) acc[ai][bj][m][n] = acc[ai][bj][m][n] * rs[ai][m];
            }
            bf16_t* tp = T + (size_t)(colt - t_col0) * ldt + row0;
#pragma unroll
            for (int bj = 0; bj < 2; ++bj) {
#pragma unroll
                for (int n = 0; n < 2; ++n)
#pragma unroll
                    for (int j = 0; j < 4; ++j) {
#pragma unroll
                        for (int ai = 0; ai < 2; ++ai)
#pragma unroll
                            for (int m = 0; m < 4; ++m) tp[ai * HALF + m * 16] = (bf16_t)(cvt_pk_bf16(acc[ai][bj][m][n][j], 0.f) & 0xffffu);
                        tp += ldt; asm volatile("" : "+v"(tp)); }
                tp += (size_t)120 * ldt; asm volatile("" : "+v"(tp)); }
        } else {
            bf16_t* rowp = R + (size_t)row0 * ldr + (colt - r_col0);
            float rsa[2][4];
            if (ssp) load_row_scales(ssp, row0, fq, rsa);
            else {
#pragma unroll
                for (int ai = 0; ai < 2; ++ai)
#pragma unroll
                    for (int m = 0; m < 4; ++m) rsa[ai][m] = 1.0f; }
#pragma unroll
            for (int ai = 0; ai < 2; ++ai) {
#pragma unroll
                for (int m = 0; m < 4; ++m) { const float rs = rsa[ai][m];
#pragma unroll
                    for (int bj = 0; bj < 2; ++bj) { const f32x4 v0 = acc[ai][bj][m][0] * rs, v1 = acc[ai][bj][m][1] * rs;
                        u32x4 w; w.x = cvt_pk_bf16(v0[0], v0[1]); w.y = cvt_pk_bf16(v0[2], v0[3]); w.z = cvt_pk_bf16(v1[0], v1[1]); w.w = cvt_pk_bf16(v1[2], v1[3]);
                        *(u32x4*)(rowp + bj * HALF) = w; }
                    rowp += (size_t)16 * ldr; asm volatile("" : "+v"(rowp) :: "memory"); }
                rowp += (size_t)64 * ldr; asm volatile("" : "+v"(rowp)); }
        }
    }
};
struct EpiResid {
    static constexpr bool PERM = false, AFTER_DRAIN = false;
    bf16_t* xb; int ldc; float* ssp;
    __device__ __forceinline__ void operator()(f32x4 (&acc)[2][2][4][2], const Unit& u, int wr, int wc, int fr, int fq) const {
        const int col0 = u.pn * BM + wc * 32 + 4 * fq;
#pragma unroll
        for (int ai = 0; ai < 2; ++ai) {
            unsigned long long old[4][2][2];
#pragma unroll
            for (int m = 0; m < 4; ++m) { const size_t off = (size_t)(u.pm * BM + ai * HALF + wr * 64 + m * 16 + fr) * ldc + col0;
#pragma unroll
                for (int bj = 0; bj < 2; ++bj)
#pragma unroll
                    for (int n = 0; n < 2; ++n) old[m][bj][n] = *(const unsigned long long*)(xb + off + bj * HALF + n * 16); }
#pragma unroll
            for (int m = 0; m < 4; ++m) { const int row = u.pm * BM + ai * HALF + wr * 64 + m * 16 + fr; const size_t off = (size_t)row * ldc + col0; float sq = 0.f;
#pragma unroll
                for (int bj = 0; bj < 2; ++bj)
#pragma unroll
                    for (int n = 0; n < 2; ++n) { const unsigned long long b = old[m][bj][n];
                        const unsigned blo = (unsigned)b, bhi = (unsigned)(b >> 32);
                        f32x4 v; v[0] = __builtin_bit_cast(float, blo << 16); v[1] = __builtin_bit_cast(float, blo & 0xffff0000u); v[2] = __builtin_bit_cast(float, bhi << 16); v[3] = __builtin_bit_cast(float, bhi & 0xffff0000u);
                        v = v + acc[ai][bj][m][n];
                        sq += (v[0] * v[0] + v[1] * v[1]) + (v[2] * v[2] + v[3] * v[3]);
                        *(unsigned long long*)(xb + off + bj * HALF + n * 16) = (unsigned long long)cvt_pk_bf16(v[0], v[1]) | ((unsigned long long)cvt_pk_bf16(v[2], v[3]) << 32); }
                sq += __shfl_xor(sq, 16); sq += __shfl_xor(sq, 32);
                if (fq == 0) ssp[(size_t)row * 16 + 4 * u.pn + wc] = sq; }
            asm volatile("" ::: "memory"); }
    }
};
__device__ __forceinline__ float dppf(float old, float src, int ctrl_sel) {
    const int o = __builtin_bit_cast(int, old), v = __builtin_bit_cast(int, src); int r;
    if (ctrl_sel == 0) r = __builtin_amdgcn_update_dpp(o, v, 0x111, 0xf, 0xf, false);
    else if (ctrl_sel == 1) r = __builtin_amdgcn_update_dpp(o, v, 0x112, 0xf, 0xf, false);
    else if (ctrl_sel == 2) r = __builtin_amdgcn_update_dpp(o, v, 0x121, 0xf, 0xf, false);
    else r = __builtin_amdgcn_update_dpp(o, v, 0x122, 0xf, 0xf, false);
    return __builtin_bit_cast(float, r);
}
struct EpiConv {
    static constexpr bool PERM = true, AFTER_DRAIN = false;
    bf16_t* G; bf16_t* Fb; bf16_t* Hb; const float* cw; const float* cb; const float* ssp;
    __device__ __forceinline__ void operator()(f32x4 (&acc)[2][2][4][2], const Unit& u, int wr, int wc, int fr, int fq) const {
        constexpr int FFc = 2816, FF2c = 5632;
        const int row0 = u.pm * BM + wr * 64 + fr;
        { float rs[2][4]; load_row_scales(ssp, row0, fq, rs);
#pragma unroll
          for (int ai = 0; ai < 2; ++ai)
#pragma unroll
              for (int m = 0; m < 4; ++m)
#pragma unroll
                  for (int bj = 0; bj < 2; ++bj)
#pragma unroll
                      for (int n = 0; n < 2; ++n) acc[ai][bj][m][n] = acc[ai][bj][m][n] * rs[ai][m]; }
#pragma unroll
        for (int n = 0; n < 2; ++n) {
            const int gc0 = u.pn * 128 + wc * 32 + 8 * fq + 4 * n;
            const float* cwp = cw + gc0; asm volatile("" : "+v"(cwp));
            const f32x4 wg0 = *(const f32x4*)(cwp), wg1 = *(const f32x4*)(cwp + FF2c), wg2 = *(const f32x4*)(cwp + 2 * FF2c);
            const f32x4 wv0 = *(const f32x4*)(cwp + FFc), wv1 = *(const f32x4*)(cwp + FF2c + FFc), wv2 = *(const f32x4*)(cwp + 2 * FF2c + FFc);
            const f32x4 bg = *(const f32x4*)(cb + gc0), bv = *(const f32x4*)(cb + FFc + gc0);
            bf16_t* gp = G + (size_t)row0 * FFc + gc0;
            bf16_t* sb = Fb + ((size_t)(row0 >> 6) * 2 + (fr & 1)) * FF2c + gc0;
            bf16_t* hb = Hb + ((size_t)(row0 >> 6) * 2 + (fr & 1)) * FF2c + gc0;
#pragma unroll
            for (int ai = 0; ai < 2; ++ai) {
#pragma unroll
                for (int m = 0; m < 4; ++m) {
                    float og[4];
#pragma unroll
                    for (int j = 0; j < 4; ++j) {
                        const float vg = acc[ai][0][m][n][j], vv = acc[ai][1][m][n][j];
                        const float pg = (m > 0) ? acc[ai][0][m - 1][n][j] : 0.f, pv = (m > 0) ? acc[ai][1][m - 1][n][j] : 0.f;
                        const float g1 = dppf(dppf(0.f, pg, 2), vg, 0), g2 = dppf(dppf(0.f, pg, 3), vg, 1);
                        const float v1 = dppf(dppf(0.f, pv, 2), vv, 0), v2 = dppf(dppf(0.f, pv, 3), vv, 1);
                        const float cgate = bg[j] + wg0[j] * g2 + wg1[j] * g1 + wg2[j] * vg;
                        const float cval = bv[j] + wv0[j] * v2 + wv1[j] * v1 + wv2[j] * vv;
                        og[j] = cgate * __builtin_amdgcn_rcpf(1.0f + __builtin_amdgcn_exp2f(-1.4426950408889634f * cgate)) * cval; }
                    const unsigned long long w = (unsigned long long)cvt_pk_bf16(og[0], og[1]) | ((unsigned long long)cvt_pk_bf16(og[2], og[3]) << 32);
                    if (m == 0) {
                        if (fr >= 2) *(unsigned long long*)gp = w;
                        else { *(unsigned long long*)sb = (unsigned long long)cvt_pk_bf16(acc[ai][0][0][n][0], acc[ai][0][0][n][1]) | ((unsigned long long)cvt_pk_bf16(acc[ai][0][0][n][2], acc[ai][0][0][n][3]) << 32);
                               *(unsigned long long*)(sb + FFc) = (unsigned long long)cvt_pk_bf16(acc[ai][1][0][n][0], acc[ai][1][0][n][1]) | ((unsigned long long)cvt_pk_bf16(acc[ai][1][0][n][2], acc[ai][1][0][n][3]) << 32); }
                    } else *(unsigned long long*)gp = w;
                    if (m == 3 && fr >= 14) {
                        *(unsigned long long*)hb = (unsigned long long)cvt_pk_bf16(acc[ai][0][3][n][0], acc[ai][0][3][n][1]) | ((unsigned long long)cvt_pk_bf16(acc[ai][0][3][n][2], acc[ai][0][3][n][3]) << 32);
                        *(unsigned long long*)(hb + FFc) = (unsigned long long)cvt_pk_bf16(acc[ai][1][3][n][0], acc[ai][1][3][n][1]) | ((unsigned long long)cvt_pk_bf16(acc[ai][1][3][n][2], acc[ai][1][3][n][3]) << 32); }
                    gp += (size_t)16 * FFc; asm volatile("" : "+v"(gp) :: "memory"); }
                gp += (size_t)64 * FFc; sb += (size_t)4 * FF2c; hb += (size_t)4 * FF2c; asm volatile("" : "+v"(gp), "+v"(sb), "+v"(hb)); }
        }
    }
};

template <class Epi, class Sched, bool ALIGN_EPI = false, bool SP2 = false>
__device__ __forceinline__ void gemm_phase(PG8_LAS unsigned char* lds, const Gemm g, const Sched& S, const Epi& E) {
    int tid_o = threadIdx.x; asm volatile("" : "+v"(tid_o));
    const int tid = tid_o, wid = __builtin_amdgcn_readfirstlane(tid >> 6), lane = tid & 63, wr = wid >> 2, wc = wid & 3, fr = lane & 15, fq = lane >> 4;
    const int K = g.K, nt = K / BK;
    unsigned voffA[2], voffB[2];
#pragma unroll
    for (int i = 0; i < 2; ++i) { int R, C; stage_rc(tid * 16 + i * 8192, R, C); const int Rb = Epi::PERM ? ((R & ~31) + perm32(R & 31)) : R;
        voffA[i] = (unsigned)(R * K + C) * 2u; voffB[i] = (unsigned)(Rb * K + C) * 2u; }
    const size_t kstep = (size_t)(BK * 2);
    const size_t hstep = (size_t)HALF * K * 2;
    const size_t tstep = 2 * hstep;
    const unsigned ldsw = (unsigned)wid * 1024u;
    const int aoff = lds_byte(wr * 64 + fr, fq * 8), boff = lds_byte(wc * 32 + fr, fq * 8);
#define PG8_SA(b, h) (((b) * 2 + (h)) * HTB)
#define PG8_SB(b, h) ((4 + (b) * 2 + (h)) * HTB)
#define PG8_STAGE(bufoff, gbase, voff) do { _Pragma("unroll") for (int _i = 0; _i < 2; ++_i) \
        __builtin_amdgcn_global_load_lds((const unsigned*)((const char*)(gbase) + (voff)[_i]), (PG8_LAS unsigned*)(lds + (bufoff) + ldsw + _i * 8192), 16, 0, 0); } while (0)
#define PG8_LDA(dst, b, h) do { _Pragma("unroll") for (int m = 0; m < 4; ++m) _Pragma("unroll") for (int k = 0; k < 2; ++k) dst[m][k] = *(const PG8_LAS bf16x8*)(lds + PG8_SA(b, h) + aoff + m * 2048 + k * 1024); } while (0)
#define PG8_LDB(dst, b, h) do { _Pragma("unroll") for (int n = 0; n < 2; ++n) _Pragma("unroll") for (int k = 0; k < 2; ++k) dst[n][k] = *(const PG8_LAS bf16x8*)(lds + PG8_SB(b, h) + boff + n * 2048 + k * 1024); } while (0)
#define PG8_MMA(ai, bj, At, Bt) do { __builtin_amdgcn_s_setprio(1); _Pragma("unroll") for (int m = 0; m < 4; ++m) _Pragma("unroll") for (int n = 0; n < 2; ++n) _Pragma("unroll") for (int k = 0; k < 2; ++k) \
        acc[ai][bj][m][n] = __builtin_amdgcn_mfma_f32_16x16x32_bf16(Bt[n][k], At[m][k], acc[ai][bj][m][n], 0, 0, 0); __builtin_amdgcn_s_setprio(0); } while (0)
#define PG8_WAIT_V(n) asm volatile("s_waitcnt vmcnt(" #n ")" ::: "memory")
#define PG8_WAIT_L(n) asm volatile("s_waitcnt lgkmcnt(" #n ")" ::: "memory")
#define PG8_BAR __builtin_amdgcn_s_barrier()
#define PG8_SCHED __builtin_amdgcn_sched_barrier(0)
    Unit cur, nxt; int ui = 0;
    if (!S.next(0, cur)) return;
    f32x4 acc[2][2][4][2];
#pragma unroll
    for (int a = 0; a < 2; ++a)
#pragma unroll
        for (int b = 0; b < 2; ++b)
#pragma unroll
            for (int m = 0; m < 4; ++m)
#pragma unroll
                for (int n = 0; n < 2; ++n) acc[a][b][m][n] = (f32x4){0.f, 0.f, 0.f, 0.f};
    bf16x8 At[4][2], B0[2][2], B1[2][2];
    const char* cA = (const char*)g.A + (size_t)cur.pm * tstep; const char* cB = (const char*)g.Bt + (size_t)cur.pn * tstep;
    S.a_ready(cur);
    if constexpr (SP2) {
        PG8_STAGE(PG8_SB(0, 0), cB, voffB); PG8_STAGE(PG8_SB(0, 1), cB + hstep, voffB); PG8_STAGE(PG8_SA(0, 0), cA, voffA); PG8_STAGE(PG8_SA(0, 1), cA + hstep, voffA);
        if (wr == 1) PG8_BAR;
        PG8_WAIT_V(2); PG8_BAR;
        PG8_STAGE(PG8_SB(1, 0), cB + kstep, voffB); PG8_STAGE(PG8_SA(1, 0), cA + kstep, voffA); PG8_STAGE(PG8_SB(1, 1), cB + hstep + kstep, voffB);
        PG8_WAIT_V(6); PG8_BAR;
    } else {
        PG8_STAGE(PG8_SB(0, 0), cB, voffB); PG8_STAGE(PG8_SA(0, 0), cA, voffA); PG8_STAGE(PG8_SB(0, 1), cB + hstep, voffB); PG8_STAGE(PG8_SA(0, 1), cA + hstep, voffA);
        if (wr == 1) PG8_BAR;
        PG8_WAIT_V(4); PG8_BAR;
        PG8_STAGE(PG8_SB(1, 0), cB + kstep, voffB); PG8_STAGE(PG8_SA(1, 0), cA + kstep, voffA); PG8_STAGE(PG8_SB(1, 1), cB + hstep + kstep, voffB);
        PG8_WAIT_V(6); PG8_BAR;
    }
    for (;;) {
        const bool has_next = S.next(ui + 1, nxt);
        const char* nA = has_next ? (const char*)g.A + (size_t)nxt.pm * tstep : cA; const char* nB = has_next ? (const char*)g.Bt + (size_t)nxt.pn * tstep : cB;
        for (int t = 0; t < nt; t += 2) {
            const bool last = (t == nt - 2);
            const char* a1 = cA + (size_t)(t + 1) * kstep;
            const char* a2 = last ? nA : cA + (size_t)(t + 2) * kstep; const char* b2 = last ? nB : cB + (size_t)(t + 2) * kstep;
            const char* a3 = a2 + kstep; const char* b3 = b2 + kstep;
            if (last && has_next) S.a_ready(nxt);
            if constexpr (SP2) {
            PG8_LDB(B0, 0, 0); PG8_LDB(B1, 0, 1); PG8_SCHED; PG8_LDA(At, 0, 0); PG8_STAGE(PG8_SA(1, 1), a1 + hstep, voffA);
            PG8_WAIT_V(8); PG8_WAIT_L(0); PG8_BAR; PG8_MMA(0, 0, At, B0); PG8_MMA(0, 1, At, B1); PG8_BAR; PG8_SCHED;
            PG8_LDA(At, 0, 1); PG8_STAGE(PG8_SB(0, 0), b2, voffB); PG8_STAGE(PG8_SB(0, 1), b2 + hstep, voffB); PG8_STAGE(PG8_SA(0, 0), a2, voffA);
            PG8_WAIT_V(8); PG8_WAIT_L(0); PG8_BAR; PG8_MMA(1, 0, At, B0); PG8_MMA(1, 1, At, B1); PG8_BAR; PG8_SCHED;
            PG8_LDB(B0, 1, 0); PG8_LDB(B1, 1, 1); PG8_SCHED; PG8_LDA(At, 1, 0); PG8_STAGE(PG8_SA(0, 1), a2 + hstep, voffA);
            PG8_WAIT_V(8); PG8_WAIT_L(0); PG8_BAR; PG8_MMA(0, 0, At, B0); PG8_MMA(0, 1, At, B1); PG8_BAR; PG8_SCHED;
            PG8_LDA(At, 1, 1); PG8_STAGE(PG8_SB(1, 0), b3, voffB); PG8_STAGE(PG8_SB(1, 1), b3 + hstep, voffB); PG8_STAGE(PG8_SA(1, 0), a3, voffA);
            PG8_WAIT_V(8); PG8_WAIT_L(0); PG8_BAR; PG8_MMA(1, 0, At, B0); PG8_MMA(1, 1, At, B1); PG8_BAR; PG8_SCHED;
            } else {
            PG8_LDB(B0, 0, 0); PG8_SCHED; PG8_LDA(At, 0, 0); PG8_STAGE(PG8_SA(1, 1), a1 + hstep, voffA);
            PG8_WAIT_L(8); PG8_BAR; PG8_WAIT_L(0); PG8_MMA(0, 0, At, B0); PG8_BAR; PG8_SCHED;
            PG8_LDB(B1, 0, 1); PG8_STAGE(PG8_SB(0, 0), b2, voffB);
            PG8_BAR; PG8_WAIT_L(0); PG8_MMA(0, 1, At, B1); PG8_BAR;
            PG8_LDA(At, 0, 1); PG8_STAGE(PG8_SA(0, 0), a2, voffA);
            PG8_BAR; PG8_WAIT_L(0); PG8_MMA(1, 0, At, B0); PG8_BAR; PG8_SCHED;
            PG8_STAGE(PG8_SB(0, 1), b2 + hstep, voffB);
            PG8_WAIT_V(6); PG8_BAR; PG8_MMA(1, 1, At, B1); PG8_BAR;
            PG8_LDB(B0, 1, 0); PG8_SCHED; PG8_LDA(At, 1, 0); PG8_STAGE(PG8_SA(0, 1), a2 + hstep, voffA);
            PG8_WAIT_L(8); PG8_BAR; PG8_WAIT_L(0); PG8_MMA(0, 0, At, B0); PG8_BAR; PG8_SCHED;
            PG8_LDB(B1, 1, 1); PG8_STAGE(PG8_SB(1, 0), b3, voffB);
            PG8_BAR; PG8_WAIT_L(0); PG8_MMA(0, 1, At, B1); PG8_BAR;
            PG8_LDA(At, 1, 1); PG8_STAGE(PG8_SA(1, 0), a3, voffA);
            PG8_BAR; PG8_WAIT_L(0); PG8_MMA(1, 0, At, B0); PG8_BAR; PG8_SCHED;
            PG8_STAGE(PG8_SB(1, 1), b3 + hstep, voffB);
            PG8_WAIT_V(6); PG8_BAR; PG8_MMA(1, 1, At, B1); PG8_BAR;
            }
        }
        if constexpr (ALIGN_EPI) { if (wr == 0) PG8_BAR; }
        if constexpr (!Epi::AFTER_DRAIN) { E(acc, cur, wr, wc, fr, fq); S.done(cur); }
        if (!has_next) break;
#pragma unroll
        for (int a = 0; a < 2; ++a)
#pragma unroll
            for (int b = 0; b < 2; ++b)
#pragma unroll
                for (int m = 0; m < 4; ++m)
#pragma unroll
                    for (int n = 0; n < 2; ++n) acc[a][b][m][n] = (f32x4){0.f, 0.f, 0.f, 0.f};
        cur = nxt; cA = nA; cB = nB; ++ui;
        if constexpr (ALIGN_EPI) { if (wr == 1) PG8_BAR; }
    }
    PG8_WAIT_V(0);
    if constexpr (!ALIGN_EPI) { if (wr == 0) PG8_BAR; }
    PG8_BAR;
    if constexpr (Epi::AFTER_DRAIN) { E.fused(acc, cur, wr, wc, fr, fq, lds, wid, lane); S.done(cur); }
#undef PG8_SA
#undef PG8_SB
#undef PG8_STAGE
#undef PG8_LDA
#undef PG8_LDB
#undef PG8_MMA
#undef PG8_WAIT_V
#undef PG8_WAIT_L
#undef PG8_BAR
#undef PG8_SCHED
}
}

#define LAS __attribute__((address_space(3)))
using pg8::bf16_t;
typedef short bf16x8 __attribute__((ext_vector_type(8)));
typedef short s16x4 __attribute__((ext_vector_type(4)));
typedef float f32x16 __attribute__((ext_vector_type(16)));
typedef float f32x4 __attribute__((ext_vector_type(4)));
typedef float f32x2_t __attribute__((ext_vector_type(2)));
typedef __bf16 bf16x2_t __attribute__((ext_vector_type(2)));
typedef unsigned u32x4v __attribute__((ext_vector_type(4)));
typedef unsigned u32x2v __attribute__((ext_vector_type(2)));

constexpr int NB = 16, SEQ = 4096, DM = 1024, MTOK = NB * SEQ, NLAYER = 4, MEMLEN = 256, MMEM = NB * MEMLEN;
constexpr int NIN = 3656, NINP = 3840, PW = 2816, FF = 2816, FF2 = 5632;
constexpr int P_AQ = 0, P_AK = 512, P_BQ = 1024, P_BK = 1280, P_CQ = 1536, P_CK = 1792, P_IQ = 2048, P_IK = 2560, P_IW = 2624;
constexpr int V_A = 0, V_B = 512, V_C = 768;
constexpr int TABN = 4352, TABOFF = 256;
constexpr float NEGV = -1.0e30f, LOG2E = 1.4426950408889634f, EPSN = 1e-6f;
constexpr int FCH = 2, FROWS = MTOK / FCH;

constexpr size_t MiB = (size_t)1 << 20;
constexpr size_t WS_LAM = 0, WS_BAR = 4096, WS_BAR_BYTES = 16384, WS_TAB = 65536, WS_WT = 2 * MiB;
constexpr size_t WT_IN = 0, WT_OUT = 30 * MiB, WT_MQ = 38 * MiB, WT_MO = 46 * MiB, WT_MKV = 54 * MiB, WT_UP = 70 * MiB, WT_DN = 114 * MiB;
constexpr size_t WS_XH = 138 * MiB, WS_MIX = 266 * MiB, WS_P = 394 * MiB, WS_VT = 746 * MiB, WS_BITS = 874 * MiB, WS_MEMK = 906 * MiB, WS_MEMVT = 938 * MiB, WS_MEMH = 970 * MiB, WS_STASH = 978 * MiB, WS_SS = 1010 * MiB, WS_END = 1022 * MiB;
constexpr size_t WS_G = WS_MIX, WS_FB = WS_MIX + 352 * MiB, WS_HB = WS_FB + 22 * MiB, WS_QM = WS_P;
constexpr int LDS_BYTES = 147456;

__device__ __forceinline__ unsigned cvtpk(float lo, float hi) { f32x2_t v = {lo, hi}; bf16x2_t b = __builtin_convertvector(v, bf16x2_t); return __builtin_bit_cast(unsigned, b); }
__device__ __forceinline__ float bf2f(bf16_t v) { return __builtin_bit_cast(float, (unsigned)v << 16); }
__device__ __forceinline__ float swap32_add(float v) { auto rr = __builtin_amdgcn_permlane32_swap(__float_as_uint(v), __float_as_uint(v), false, false); return __uint_as_float(rr[0]) + __uint_as_float(rr[1]); }
__device__ __forceinline__ float swap32_max(float v) { auto rr = __builtin_amdgcn_permlane32_swap(__float_as_uint(v), __float_as_uint(v), false, false); return fmaxf(__uint_as_float(rr[0]), __uint_as_float(rr[1])); }
__device__ __forceinline__ float max3f(float a, float b, float c) { float r; asm("v_max3_f32 %0, %1, %2, %3" : "=v"(r) : "v"(a), "v"(b), "v"(c)); return r; }
__device__ __forceinline__ float reluf(float a) { float r; asm("v_max_f32_e32 %0, 0, %1" : "=v"(r) : "v"(a)); return r; }
__device__ __forceinline__ float wave_sum(float v) {
#pragma unroll
    for (int o = 1; o < 64; o <<= 1) v += __shfl_xor(v, o);
    return v;
}

__device__ __forceinline__ void conv_item(const float* W, int ldw, int srccol0, int nvalid, const float* gain, bf16_t* dst, int K, int k0, float* scr, int lane) {
    const int c4 = (lane & 7) * 4, kr = lane >> 3;
    if (nvalid == 32 && ((ldw | srccol0) & 3) == 0) {
#pragma unroll
        for (int i = 0; i < 8; ++i) { const int kk = 8 * i + kr; f32x4 v = *(const f32x4*)(W + (size_t)(k0 + kk) * ldw + srccol0 + c4);
            if (gain) v = v * gain[k0 + kk];
            scr[kk * 33 + c4] = v[0]; scr[kk * 33 + c4 + 1] = v[1]; scr[kk * 33 + c4 + 2] = v[2]; scr[kk * 33 + c4 + 3] = v[3]; }
    } else {
#pragma unroll 8
        for (int i = 0; i < 32; ++i) { const int kk = 2 * i + (lane >> 5), c = lane & 31;
            float v = (c < nvalid) ? W[(size_t)(k0 + kk) * ldw + srccol0 + c] : 0.f;
            if (gain) v *= gain[k0 + kk];
            scr[kk * 33 + c] = v; }
    }
    __builtin_amdgcn_fence(__ATOMIC_RELEASE, "wavefront"); __builtin_amdgcn_wave_barrier();
    const int c8 = lane & 7;
#pragma unroll
    for (int j = 0; j < 4; ++j) { const int n = (lane >> 3) + 8 * j; const float* sp = scr + (8 * c8) * 33 + n;
        u32x4v o; o.x = cvtpk(sp[0 * 33], sp[1 * 33]); o.y = cvtpk(sp[2 * 33], sp[3 * 33]); o.z = cvtpk(sp[4 * 33], sp[5 * 33]); o.w = cvtpk(sp[6 * 33], sp[7 * 33]);
        *(u32x4v*)(dst + (size_t)n * K + k0 + 8 * c8) = o; }
    __builtin_amdgcn_fence(__ATOMIC_RELEASE, "wavefront"); __builtin_amdgcn_wave_barrier();
}
__device__ __forceinline__ int win_map(int n0) {
    if (n0 < 512) return 1024 + n0;
    if (n0 < 768) return 2048 + (n0 - 512);
    if (n0 < 1024) return 2816 + (n0 - 768);
    if (n0 < 2048) return n0 - 1024;
    if (n0 < 2560) return n0 - 512;
    if (n0 < 3072) return n0 - 256;
    return n0;
}
__device__ __forceinline__ void conv_one(const float* W, int K, int Nsrc, int srccol0, int ncols_src, const float* gain, bf16_t* dst, int Ndst, int map, int it, float* scr, int lane) {
    const int nblk = Ndst / 32; const int kb = it / nblk, nb = it % nblk, n0 = nb * 32;
    int sc, nv;
    if (map == 1) { sc = win_map(n0); nv = Nsrc - sc; } else if (map == 2) { const int tl = n0 >> 8, wi = n0 & 255; sc = wi < 128 ? tl * 128 + wi : FF + tl * 128 + (wi - 128); nv = 32; } else { sc = srccol0 + n0; nv = ncols_src - n0; }
    nv = nv < 0 ? 0 : (nv > 32 ? 32 : nv);
    conv_item(W, Nsrc, sc, nv, gain, dst + (size_t)n0 * K, K, kb * 64, scr, lane);
}
__device__ __forceinline__ void conv_mat(const float* W, int K, int Nsrc, int srccol0, int ncols_src, const float* gain, bf16_t* dst, int Ndst, int map, int gw, int NGW, float* scr, int lane) {
    const int nblk = Ndst / 32, nitems = (K / 64) * nblk;
    for (int it = gw; it < nitems; it += NGW) { const int kb = it / nblk, nb = it % nblk, n0 = nb * 32;
        int sc, nv;
        if (map == 1) { sc = win_map(n0); nv = Nsrc - sc; } else if (map == 2) { const int tl = n0 >> 8, wi = n0 & 255; sc = wi < 128 ? tl * 128 + wi : FF + tl * 128 + (wi - 128); nv = 32; } else { sc = srccol0 + n0; nv = ncols_src - n0; }
        nv = nv < 0 ? 0 : (nv > 32 ? 32 : nv);
        conv_item(W, Nsrc, sc, nv, gain, dst + (size_t)n0 * K, K, kb * 64, scr, lane); }
}
__device__ __forceinline__ void norm_rows(const float* X, bf16_t* XH, int nrows, int gw, int NGW, int lane) {
    for (int m = gw; m < nrows; m += NGW) { const f32x4* xr = (const f32x4*)(X + (size_t)m * DM) + lane;
        f32x4 v[4]; float s = 0.f;
#pragma unroll
        for (int j = 0; j < 4; ++j) { v[j] = xr[64 * j]; s += (v[j].x * v[j].x + v[j].y * v[j].y) + (v[j].z * v[j].z + v[j].w * v[j].w); }
        const float rstd = 1.0f / sqrtf(wave_sum(s) * (1.f / DM) + EPSN);
        u32x2v* o8 = (u32x2v*)(XH + (size_t)m * DM) + lane;
#pragma unroll
        for (int j = 0; j < 4; ++j) { u32x2v w; w.x = cvtpk(v[j].x * rstd, v[j].y * rstd); w.y = cvtpk(v[j].z * rstd, v[j].w * rstd); o8[64 * j] = w; } }
}
__device__ __forceinline__ void cast_rows(const float* X, bf16_t* XB, float* ssp, int nrows, int gw, int NGW, int lane) {
    for (int m = gw; m < nrows; m += NGW) { const f32x4* xr = (const f32x4*)(X + (size_t)m * DM) + lane;
        f32x4 v[4]; float s = 0.f;
#pragma unroll
        for (int j = 0; j < 4; ++j) { v[j] = xr[64 * j]; s += (v[j].x * v[j].x + v[j].y * v[j].y) + (v[j].z * v[j].z + v[j].w * v[j].w); }
        s = wave_sum(s);
        u32x2v* o8 = (u32x2v*)(XB + (size_t)m * DM) + lane;
#pragma unroll
        for (int j = 0; j < 4; ++j) { u32x2v w; w.x = cvtpk(v[j].x, v[j].y); w.y = cvtpk(v[j].z, v[j].w); o8[64 * j] = w; }
        if (lane < 16) ssp[(size_t)m * 16 + lane] = lane == 0 ? s : 0.f; }
}
__device__ __forceinline__ void final_rows(const bf16_t* XB, float* OUT, const float* g, int gw, int NGW, int lane) {
    const f32x4* gr = (const f32x4*)g + lane;
    for (int m = gw; m < MTOK; m += 2 * NGW) {
        const int m1 = m + NGW; const bool has1 = m1 < MTOK;
        const u32x2v* xr0 = (const u32x2v*)(XB + (size_t)m * DM) + lane; const u32x2v* xr1 = (const u32x2v*)(XB + (size_t)(has1 ? m1 : m) * DM) + lane;
        u32x2v w0[4], w1[4];
#pragma unroll
        for (int j = 0; j < 4; ++j) { w0[j] = xr0[64 * j]; w1[j] = xr1[64 * j]; }
        f32x4 v0[4], v1[4]; float s0 = 0.f, s1 = 0.f;
#pragma unroll
        for (int j = 0; j < 4; ++j) {
            v0[j][0] = __builtin_bit_cast(float, w0[j].x << 16); v0[j][1] = __builtin_bit_cast(float, w0[j].x & 0xffff0000u); v0[j][2] = __builtin_bit_cast(float, w0[j].y << 16); v0[j][3] = __builtin_bit_cast(float, w0[j].y & 0xffff0000u);
            v1[j][0] = __builtin_bit_cast(float, w1[j].x << 16); v1[j][1] = __builtin_bit_cast(float, w1[j].x & 0xffff0000u); v1[j][2] = __builtin_bit_cast(float, w1[j].y << 16); v1[j][3] = __builtin_bit_cast(float, w1[j].y & 0xffff0000u);
            s0 += (v0[j].x * v0[j].x + v0[j].y * v0[j].y) + (v0[j].z * v0[j].z + v0[j].w * v0[j].w); s1 += (v1[j].x * v1[j].x + v1[j].y * v1[j].y) + (v1[j].z * v1[j].z + v1[j].w * v1[j].w); }
#pragma unroll
        for (int o = 1; o < 64; o <<= 1) { s0 += __shfl_xor(s0, o); s1 += __shfl_xor(s1, o); }
        const float r0 = 1.0f / sqrtf(s0 * (1.f / DM) + EPSN), r1 = 1.0f / sqrtf(s1 * (1.f / DM) + EPSN);
        f32x4* o0 = (f32x4*)(OUT + (size_t)m * DM) + lane;
#pragma unroll
        for (int j = 0; j < 4; ++j) o0[64 * j] = v0[j] * r0 * gr[64 * j];
        if (has1) { f32x4* o1 = (f32x4*)(OUT + (size_t)m1 * DM) + lane;
#pragma unroll
            for (int j = 0; j < 4; ++j) o1[64 * j] = v1[j] * r1 * gr[64 * j]; }
    }
}
__device__ __forceinline__ float lam_init_of(int l) { return l == 0 ? 0.2f : (l == 1 ? 0.35550906759096926f : (l == 2 ? 0.47071301834358416f : 0.5560582041556405f)); }

constexpr int A_KOFF = 0, A_VOFF = 67584, A_TOFF = 102400, A_WOFF = 119808;
__device__ __forceinline__ int crowc(int r) { return (r & 3) + 8 * (r >> 2); }

template <int D, int DV, bool TAB, bool BITS, int KT>
__device__ __forceinline__ void attn_pass(unsigned char* lds, const bf16_t* Qp, int ldq, const bf16_t* Kp, int ldk, const bf16_t* Vtp, int ldvt,
                                          const float* tabg, const unsigned* bitsp, int q0, int t_lo, int t_hi, int win, float c2, f32x16 (&o)[DV / 32], bool ltab) {
    constexpr int KP = D * 2 + 16, VP = KT * 2 + 8, KBUF = KT * KP, VBUF = DV * VP, DC = D / 8, VC = KT / 8, NKC = KT * DC / 512, NVC = DV * VC / 512, NSUB = KT / 64, NBW = KT / 32;
    constexpr int KOFF = 0, VOFF = 2 * KBUF, TOFF = VOFF + 2 * VBUF, WOFF = TOFF + TABN * 4;
    static_assert(WOFF + 2048 <= LDS_BYTES - 64, "attention LDS map");
    int tid_o = threadIdx.x; asm volatile("" : "+v"(tid_o));
    const int tid = tid_o, lane = tid & 63, wid = __builtin_amdgcn_readfirstlane(tid >> 6), r32 = lane & 31, hi = lane >> 5;
    float* tabL = (float*)(lds + TOFF); float* wsf = (float*)(lds + WOFF) + wid * 64;
    if (TAB && ltab) { for (int i = tid; i < TABN / 4; i += 512) ((f32x4*)tabL)[i] = ((const f32x4*)tabg)[i]; }
    bf16x8 qf[D / 16];
    { const bf16_t* qrow = Qp + (size_t)(32 * wid + r32) * ldq + 8 * hi;
#pragma unroll
      for (int kk = 0; kk < D / 16; ++kk) { const u32x4v raw = *(const u32x4v*)(qrow + kk * 16); u32x4v sc4;
#pragma unroll
          for (int e = 0; e < 4; ++e) { const float lo = __builtin_bit_cast(float, raw[e] << 16) * c2, hh = __builtin_bit_cast(float, raw[e] & 0xffff0000u) * c2; sc4[e] = cvtpk(lo, hh); }
          qf[kk] = __builtin_bit_cast(bf16x8, sc4); } }
#pragma unroll
    for (int dt = 0; dt < DV / 32; ++dt)
#pragma unroll
        for (int r = 0; r < 16; ++r) o[dt][r] = 0.f;
    float mhat = 0.f, l_run = 0.f;
    const int qpos = q0 + 32 * wid + r32, qw_lo = q0 + 32 * wid, qw_hi = qw_lo + 31;
    u32x4v kreg[NKC], vreg[NVC];
#define AT_LOAD(t) do { const int k0_ = (t) * KT; \
        _Pragma("unroll") for (int i = 0; i < NKC; ++i) { const int c = tid + i * 512, key = c / DC, ch = c % DC; kreg[i] = *(const u32x4v*)(Kp + (size_t)(k0_ + key) * ldk + ch * 8); } \
        _Pragma("unroll") for (int i = 0; i < NVC; ++i) { const int c = tid + i * 512, row = c / VC, ch = c % VC; vreg[i] = *(const u32x4v*)(Vtp + (size_t)row * ldvt + k0_ + ch * 8); } } while (0)
#define AT_STORE(buf) do { \
        _Pragma("unroll") for (int i = 0; i < NKC; ++i) { const int c = tid + i * 512, key = c / DC, ch = c % DC; *(u32x4v*)(lds + KOFF + (buf) * KBUF + key * KP + ch * 16) = kreg[i]; } \
        _Pragma("unroll") for (int i = 0; i < NVC; ++i) { const int c = tid + i * 512, row = c / VC, ch = c % VC; unsigned char* d_ = lds + VOFF + (buf) * VBUF + row * VP + ch * 16; \
            *(u32x2v*)d_ = (u32x2v){vreg[i].x, vreg[i].y}; *(u32x2v*)(d_ + 8) = (u32x2v){vreg[i].z, vreg[i].w}; } } while (0)
    AT_LOAD(t_lo); AT_STORE(0);
    unsigned wq[NBW], wn[NBW];
    const unsigned* bprow = BITS ? bitsp + (size_t)(32 * wid + r32) * 128 : nullptr;
#pragma unroll
    for (int i = 0; i < NBW; ++i) { wq[i] = 0xffffffffu; wn[i] = 0xffffffffu; if (BITS) wq[i] = bprow[NBW * t_lo + i]; }
    __syncthreads();
    int cur = 0;
    for (int t = t_lo; t < t_hi; ++t) {
        if (t + 1 < t_hi) { AT_LOAD(t + 1); if (BITS) {
#pragma unroll
            for (int i = 0; i < NBW; ++i) wn[i] = bprow[NBW * (t + 1) + i]; } }
#pragma unroll
        for (int sub = 0; sub < NSUB; ++sub) {
        const int k0 = t * KT + sub * 64;
        bool active = true;
        if (TAB) active = (k0 <= qw_hi) && (k0 + 63 >= qw_lo - win);
        if (active) {
            const unsigned char* Kl = lds + KOFF + cur * KBUF + sub * 64 * KP; const unsigned char* Vl = lds + VOFF + cur * VBUF + sub * 128;
            f32x16 p0, p1;
            unsigned w0 = 0xffffffffu, w1 = 0xffffffffu;
            if (BITS) { w0 = wq[2 * sub] >> (4 * hi); w1 = wq[2 * sub + 1] >> (4 * hi); }
            const float nm = -mhat;
            const int tj = TABN - 1 - TABOFF - qpos + k0 + 4 * hi;
            constexpr int KG = (D > 64) ? 2 : 4;
            if (D == 64) {
                bf16x8 ka[4], kb[4];
                if (TAB) {
#pragma unroll
                    for (int r = 0; r < 16; ++r) p0[r] = tabL[tj + crowc(r)]; }
#pragma unroll
                for (int kk = 0; kk < 4; ++kk) ka[kk] = *(const bf16x8*)(Kl + r32 * KP + (kk * 16 + 8 * hi) * 2);
                if (TAB) {
#pragma unroll
                    for (int r = 0; r < 16; ++r) p1[r] = tabL[tj + 32 + crowc(r)]; }
#pragma unroll
                for (int kk = 0; kk < 4; ++kk) kb[kk] = *(const bf16x8*)(Kl + (32 + r32) * KP + (kk * 16 + 8 * hi) * 2);
                __builtin_amdgcn_sched_barrier(0);
#pragma unroll
                for (int r = 0; r < 16; ++r) { if (TAB) p0[r] -= mhat; else p0[r] = nm; if (BITS) { if (!((w0 >> crowc(r)) & 1u)) p0[r] = NEGV; } }
                __builtin_amdgcn_sched_barrier(0);
#pragma unroll
                for (int kk = 0; kk < 4; ++kk) p0 = __builtin_amdgcn_mfma_f32_32x32x16_bf16(ka[kk], qf[kk], p0, 0, 0, 0);
#pragma unroll
                for (int r = 0; r < 16; ++r) { if (TAB) p1[r] -= mhat; else p1[r] = nm; if (BITS) { if (!((w1 >> crowc(r)) & 1u)) p1[r] = NEGV; } }
                __builtin_amdgcn_sched_barrier(0);
#pragma unroll
                for (int kk = 0; kk < 4; ++kk) p1 = __builtin_amdgcn_mfma_f32_32x32x16_bf16(kb[kk], qf[kk], p1, 0, 0, 0);
                __builtin_amdgcn_sched_barrier(0);
            } else {
                if (TAB) {
#pragma unroll
                    for (int r = 0; r < 16; ++r) p0[r] = tabL[tj + crowc(r)];
#pragma unroll
                    for (int r = 0; r < 16; ++r) p1[r] = tabL[tj + 32 + crowc(r)];
                    __builtin_amdgcn_sched_barrier(0);
#pragma unroll
                    for (int r = 0; r < 16; ++r) { p0[r] -= mhat; p1[r] -= mhat; }
                } else {
#pragma unroll
                    for (int r = 0; r < 16; ++r) { p0[r] = nm; p1[r] = nm; }
                }
                if (BITS) {
#pragma unroll
                    for (int r = 0; r < 16; ++r) { const int off = crowc(r); if (!((w0 >> off) & 1u)) p0[r] = NEGV; if (!((w1 >> off) & 1u)) p1[r] = NEGV; } }
#pragma unroll
                for (int k4 = 0; k4 < D / 16; k4 += KG) {
                    bf16x8 ka[KG], kb[KG];
#pragma unroll
                    for (int kk = 0; kk < KG; ++kk) { ka[kk] = *(const bf16x8*)(Kl + r32 * KP + ((k4 + kk) * 16 + 8 * hi) * 2); kb[kk] = *(const bf16x8*)(Kl + (32 + r32) * KP + ((k4 + kk) * 16 + 8 * hi) * 2); }
                    __builtin_amdgcn_sched_barrier(0);
#pragma unroll
                    for (int kk = 0; kk < KG; ++kk) { p0 = __builtin_amdgcn_mfma_f32_32x32x16_bf16(ka[kk], qf[k4 + kk], p0, 0, 0, 0); p1 = __builtin_amdgcn_mfma_f32_32x32x16_bf16(kb[kk], qf[k4 + kk], p1, 0, 0, 0); }
                    __builtin_amdgcn_sched_barrier(0);
                }
            }
            asm volatile("s_nop 15\n\ts_nop 7" : "+v"(p0), "+v"(p1));
            float mx = max3f(p0[0], p1[0], p0[1]), mx2 = max3f(p1[1], p0[2], p1[2]);
#pragma unroll
            for (int r = 3; r < 15; r += 2) { mx = max3f(mx, p0[r], p1[r]); mx2 = max3f(mx2, p0[r + 1], p1[r + 1]); }
            mx = max3f(mx, p0[15], p1[15]); mx = max3f(mx, mx2, mx2);
            mx = swap32_max(mx);
            if (__any(mx > 8.0f)) {
                const float dl = fmaxf(mx, 0.f); mhat += dl;
#pragma unroll
                for (int r = 0; r < 16; ++r) { p0[r] -= dl; p1[r] -= dl; }
                const float alpha = __builtin_amdgcn_exp2f(-dl); l_run *= alpha;
                if (hi == 0) wsf[r32] = alpha;
                __builtin_amdgcn_fence(__ATOMIC_RELEASE, "wavefront"); __builtin_amdgcn_wave_barrier();
#pragma unroll
                for (int j = 0; j < 4; ++j) { const f32x4 a4 = *(const f32x4*)(wsf + 8 * j + 4 * hi);
#pragma unroll
                    for (int dt = 0; dt < DV / 32; ++dt) { o[dt][4 * j + 0] *= a4[0]; o[dt][4 * j + 1] *= a4[1]; o[dt][4 * j + 2] *= a4[2]; o[dt][4 * j + 3] *= a4[3]; } }
                __builtin_amdgcn_fence(__ATOMIC_RELEASE, "wavefront"); __builtin_amdgcn_wave_barrier();
            }
            float rs = 0.f;
            bf16x8 vc[DV / 32];
#define AT_VLOAD(dst, g) do { _Pragma("unroll") for (int dt = 0; dt < DV / 32; ++dt) { const unsigned char* vp = Vl + (dt * 32 + r32) * VP + (16 * (g) + 4 * hi) * 2; \
                const s16x4 lo = *(const s16x4*)vp, hh = *(const s16x4*)(vp + 16); dst[dt] = (bf16x8){lo[0], lo[1], lo[2], lo[3], hh[0], hh[1], hh[2], hh[3]}; } } while (0)
#pragma unroll
            for (int g = 0; g < 4; ++g) {
                AT_VLOAD(vc, g);
                float e[8];
#pragma unroll
                for (int i = 0; i < 8; ++i) { e[i] = __builtin_amdgcn_exp2f(g < 2 ? p0[(g & 1) * 8 + i] : p1[(g & 1) * 8 + i]); rs += e[i]; }
                u32x4v pw; pw.x = cvtpk(e[0], e[1]); pw.y = cvtpk(e[2], e[3]); pw.z = cvtpk(e[4], e[5]); pw.w = cvtpk(e[6], e[7]);
                const bf16x8 pa = __builtin_bit_cast(bf16x8, pw);
                __builtin_amdgcn_sched_barrier(0);
#pragma unroll
                for (int dt = 0; dt < DV / 32; ++dt) o[dt] = __builtin_amdgcn_mfma_f32_32x32x16_bf16(pa, vc[dt], o[dt], 0, 0, 0);
                __builtin_amdgcn_sched_barrier(0x1 | 0x2 | 0x100);
            }
            l_run += rs;
#undef AT_VLOAD
        }
        }
        if (t + 1 < t_hi) AT_STORE(cur ^ 1);
        if (BITS) {
#pragma unroll
            for (int i = 0; i < NBW; ++i) wq[i] = wn[i]; }
        __syncthreads();
        cur ^= 1;
    }
#undef AT_LOAD
#undef AT_STORE
    const float lt = swap32_add(l_run);
    if (hi == 0) wsf[r32] = 1.0f / fmaxf(lt, 1e-30f);
    __builtin_amdgcn_fence(__ATOMIC_RELEASE, "wavefront"); __builtin_amdgcn_wave_barrier();
#pragma unroll
    for (int j = 0; j < 4; ++j) { const f32x4 a4 = *(const f32x4*)(wsf + 8 * j + 4 * hi);
#pragma unroll
        for (int dt = 0; dt < DV / 32; ++dt) { o[dt][4 * j + 0] *= a4[0]; o[dt][4 * j + 1] *= a4[1]; o[dt][4 * j + 2] *= a4[2]; o[dt][4 * j + 3] *= a4[3]; } }
    __builtin_amdgcn_fence(__ATOMIC_RELEASE, "wavefront"); __builtin_amdgcn_wave_barrier();
}
template <int DV>
__device__ __forceinline__ void attn_store(const f32x16 (&o)[DV / 32], bf16_t* Op, int ldo) {
    int tid_o = threadIdx.x; asm volatile("" : "+v"(tid_o));
    const int lane = tid_o & 63, wid = tid_o >> 6, r32 = lane & 31, hi = lane >> 5;
#pragma unroll
    for (int dt = 0; dt < DV / 32; ++dt)
#pragma unroll
        for (int r = 0; r < 16; ++r) { const int row = 32 * wid + crowc(r) + 4 * hi; Op[(size_t)row * ldo + dt * 32 + r32] = (bf16_t)(cvtpk(o[dt][r], 0.f) & 0xffffu); }
}
__device__ __forceinline__ void deal_unit(int it, int& b, int& h, int& qb) { const int bh = it & 63, qs = it >> 6, i = qs >> 2, s = qs & 3; b = bh >> 2; h = bh & 3; qb = (i & 1) ? (4 * i + 3 - s) : (4 * i + s); }

__device__ __forceinline__ void pk_cnt_lt(unsigned& acc, unsigned k2, unsigned mid2, unsigned one2) {
    unsigned t; asm volatile("v_pk_sub_u16 %0, %2, %3 clamp\n\tv_pk_min_u16 %0, %0, %4\n\tv_pk_add_u16 %1, %1, %0" : "=&v"(t), "+v"(acc) : "v"(mid2), "v"(k2), "v"(one2));
}
__device__ __forceinline__ int red32(int v) {
    v += __builtin_amdgcn_mov_dpp(v, 0xB1, 0xf, 0xf, true);
    v += __builtin_amdgcn_mov_dpp(v, 0x4E, 0xf, 0xf, true);
    v += __builtin_amdgcn_mov_dpp(v, 0x141, 0xf, 0xf, true);
    v += __builtin_amdgcn_mov_dpp(v, 0x140, 0xf, 0xf, true);
    v += __builtin_amdgcn_ds_swizzle(v, 0x401F);
    return v;
}
__device__ __forceinline__ unsigned ltu(unsigned a, unsigned b) { unsigned d; asm volatile("v_sub_u32 %0, %1, %2\n\tv_lshrrev_b32 %0, 31, %0" : "=v"(d) : "v"(a), "v"(b)); return d; }
__device__ __forceinline__ unsigned pk_flag_gt(unsigned k2, unsigned T2, unsigned one2) { unsigned t; asm volatile("v_pk_sub_u16 %0, %1, %2 clamp\n\tv_pk_min_u16 %0, %0, %3" : "=&v"(t) : "v"(k2), "v"(T2), "v"(one2)); return t; }
__device__ __forceinline__ int scan32_incl(int x, int lane) {
    x += __builtin_amdgcn_update_dpp(0, x, 0x111, 0xf, 0xf, true);
    x += __builtin_amdgcn_update_dpp(0, x, 0x112, 0xf, 0xf, true);
    x += __builtin_amdgcn_update_dpp(0, x, 0x114, 0xf, 0xf, true);
    x += __builtin_amdgcn_update_dpp(0, x, 0x118, 0xf, 0xf, true);
    const int r15 = __builtin_amdgcn_readlane(x, 15), r47 = __builtin_amdgcn_readlane(x, 47);
    x += (lane & 16) ? ((lane & 32) ? r47 : r15) : 0;
    return x;
}
template <int NCH>
__device__ __forceinline__ void idx_select(const unsigned short* sc, unsigned* bits, size_t tok0, int tid) {
    const int row = tid >> 5, j = tid & 31, lane = tid & 63;
    unsigned kw[4 * NCH];
    { const u32x4v* src = (const u32x4v*)(sc + row * 4096) + j;
#pragma unroll
      for (int i = 0; i < NCH; ++i) { const u32x4v v = src[i * 32]; kw[4 * i] = v.x; kw[4 * i + 1] = v.y; kw[4 * i + 2] = v.z; kw[4 * i + 3] = v.w; } }
    const unsigned one2 = 0x00010001u;
    unsigned lo = 1u, hi_ = 0xFFFFu;
#pragma unroll 1
    for (int it = 0; it < 16; ++it) { const unsigned mid = (lo + hi_ + 1u) >> 1, mid2 = mid | (mid << 16);
        unsigned c2a = 0u, c2b = 0u;
#pragma unroll
        for (int i = 0; i < 4 * NCH; i += 2) { pk_cnt_lt(c2a, kw[i], mid2, one2); pk_cnt_lt(c2b, kw[i + 1], mid2, one2); }
        int cnt = 8 * NCH - (int)((c2a & 0xFFFFu) + (c2a >> 16) + (c2b & 0xFFFFu) + (c2b >> 16));
        cnt = red32(cnt);
        if (cnt >= 256) lo = mid; else hi_ = mid - 1u;
        if (cnt == 256) hi_ = mid;
        if (__all(lo == hi_)) break; }
    const unsigned T = lo, T2 = T | (T << 16);
    unsigned gm[NCH], em[NCH]; int cgt = 0;
#pragma unroll
    for (int i = 0; i < NCH; ++i) { unsigned g8 = 0u, e8 = 0u;
#pragma unroll
        for (int w = 0; w < 4; ++w) { const unsigned g2 = pk_flag_gt(kw[4 * i + w], T2, one2), l2 = pk_flag_gt(T2, kw[4 * i + w], one2), e2 = one2 - g2 - l2;
            g8 |= ((g2 | (g2 >> 15)) & 3u) << (2 * w); e8 |= ((e2 | (e2 >> 15)) & 3u) << (2 * w); }
        gm[i] = g8; em[i] = e8; cgt += __builtin_popcount(g8); }
    const int need = 256 - red32(cgt);
    int carry = 0;
    unsigned char* brow = (unsigned char*)(bits + (tok0 + row) * 128);
#pragma unroll
    for (int i = 0; i < NCH; ++i) { const int ec = __builtin_popcount(em[i]); const int incl = scan32_incl(ec, lane);
        const int quota = need - carry - (incl - ec);
        unsigned se = (quota >= ec) ? em[i] : 0u;
        if (__any(quota > 0 && quota < ec)) { unsigned m = em[i], r = 0u;
#pragma unroll
            for (int t = 0; t < 8; ++t) { const unsigned b = m & (0u - m); if (t < quota) r |= b; m ^= b; }
            if (quota > 0 && quota < ec) se = r; }
        carry += (lane & 32) ? __builtin_amdgcn_readlane(incl, 63) : __builtin_amdgcn_readlane(incl, 31);
        brow[i * 32 + j] = (unsigned char)(gm[i] | se); }
    if (NCH < 16) { unsigned* zr = (unsigned*)(brow + NCH * 32);
#pragma unroll
        for (int i = 0; i < (16 - NCH) * 8; i += 32) if (i + j < (16 - NCH) * 8) zr[i + j] = 0u; }
}

__device__ __forceinline__ void idx_unit(unsigned char* lds, const bf16_t* P, int b, int qb16, unsigned* bits) {
    int tid_o = threadIdx.x; asm volatile("" : "+v"(tid_o));
    const int tid = tid_o, lane = tid & 63, wid = __builtin_amdgcn_readfirstlane(tid >> 6), r32 = lane & 31, hi = lane >> 5;
    unsigned short* sc = (unsigned short*)lds;
    float* wl = (float*)(lds + 131072);
    const int t0 = qb16 * 16; const size_t tokb = (size_t)b * SEQ, tok0 = tokb + t0;
    const int nscan = ((t0 + 16 + 511) >> 9) << 9;
    const int ncomp = ((t0 + 16 + 31) / 32);
    const int nblk = ncomp;
    if (tid < 128) wl[tid] = bf2f(P[(tok0 + (tid >> 3)) * PW + P_IW + (tid & 7)]) * (0.35355339059327373f * 0.125f);
    bf16x8 aq[4][4];
#pragma unroll
    for (int rb = 0; rb < 4; ++rb) { const bf16_t* ap = P + (tok0 + rb * 4 + (r32 >> 3)) * PW + P_IQ + (r32 & 7) * 64 + 8 * hi;
#pragma unroll
        for (int kk = 0; kk < 4; ++kk) aq[rb][kk] = *(const bf16x8*)(ap + kk * 16); }
    __syncthreads();
    f32x4 wreg[16];
#pragma unroll
    for (int q = 0; q < 16; ++q) wreg[q] = *(const f32x4*)(wl + q * 8 + 4 * hi);
    bf16x8 bk[4], bn[4];
    { const bf16_t* kp = P + (tokb + (wid < nblk ? wid : 0) * 32 + r32) * PW + P_IK + 8 * hi;
#pragma unroll
      for (int kk = 0; kk < 4; ++kk) { bk[kk] = *(const bf16x8*)(kp + kk * 16); bn[kk] = bk[kk]; } }
    for (int blk = wid; blk < nblk; blk += 8) {
        const int key = blk * 32 + r32;
        if (blk + 8 < nblk) { const bf16_t* kp = P + (tokb + key + 256) * PW + P_IK + 8 * hi;
#pragma unroll
            for (int kk = 0; kk < 4; ++kk) bn[kk] = *(const bf16x8*)(kp + kk * 16); }
#pragma unroll
        for (int rb = 0; rb < 4; ++rb) {
            f32x16 c;
#pragma unroll
            for (int r = 0; r < 16; ++r) c[r] = 0.f;
#pragma unroll
            for (int kk = 0; kk < 4; ++kk) c = __builtin_amdgcn_mfma_f32_32x32x16_bf16(aq[rb][kk], bk[kk], c, 0, 0, 0);
            asm volatile("s_nop 15\n\ts_nop 7" : "+v"(c));
            float tq0, tq1, tq2, tq3;
#define IDX_TOT(j) ({ const f32x4 w4 = wreg[rb * 4 + (j)]; \
                const float part = w4[0] * reluf(c[4 * (j)]) + w4[1] * reluf(c[4 * (j) + 1]) + w4[2] * reluf(c[4 * (j) + 2]) + w4[3] * reluf(c[4 * (j) + 3]); swap32_add(part); })
            tq0 = IDX_TOT(0); tq1 = IDX_TOT(1); tq2 = IDX_TOT(2); tq3 = IDX_TOT(3);
#undef IDX_TOT
            const float ts0 = hi ? tq2 : tq0, ts1 = hi ? tq3 : tq1;
#pragma unroll
            for (int jj = 0; jj < 2; ++jj) { const float tv = jj ? ts1 : ts0; const int q = rb * 4 + 2 * hi + jj;
                unsigned short kv = 0;
                if (key <= t0 + q) { const _Float16 hv = (_Float16)tv; const unsigned short hb = __builtin_bit_cast(unsigned short, hv); kv = (hb & 0x8000u) ? (unsigned short)~hb : (unsigned short)(hb | 0x8000u); }
                sc[q * 4096 + key] = kv; }
        }
#pragma unroll
        for (int kk = 0; kk < 4; ++kk) bk[kk] = bn[kk];
    }
    { const int z0 = ncomp * 32, zn = (nscan - z0) >> 3;
      for (int e = tid; e < zn * 16; e += 512) { const int r = e / zn, c = e - r * zn; *(u32x4v*)(sc + r * 4096 + z0 + 8 * c) = (u32x4v){0u, 0u, 0u, 0u}; } }
    __syncthreads();
    switch (nscan >> 9) {
        case 1: idx_select<2>(sc, bits, tok0, tid); break;
        case 2: idx_select<4>(sc, bits, tok0, tid); break;
        case 3: idx_select<6>(sc, bits, tok0, tid); break;
        case 4: idx_select<8>(sc, bits, tok0, tid); break;
        case 5: idx_select<10>(sc, bits, tok0, tid); break;
        case 6: idx_select<12>(sc, bits, tok0, tid); break;
        case 7: idx_select<14>(sc, bits, tok0, tid); break;
        default: idx_select<16>(sc, bits, tok0, tid); break;
    }
    __syncthreads();
}

struct MixCtx { const bf16_t* P; const bf16_t* VT; bf16_t* MIX; const float* tabs; const unsigned* bits; const float* subln_base; const float* lamv; int l; float* stash; int nthr; };

__device__ __forceinline__ void unitA(unsigned char* lds, const MixCtx& c, int b, int h, int qb, bool ltab) {
    const int q0 = qb * 256; const size_t tokb = (size_t)b * SEQ; const int t_hi = (q0 + 256) / 128;
    const float c2 = 0.125f * LOG2E;
    f32x16 oa[4], ob[4];
    attn_pass<64, 128, true, false, 128>(lds, c.P + (tokb + q0) * PW + P_AQ + h * 128, PW, c.P + tokb * PW + P_AK + h * 128, PW, c.VT + (size_t)(V_A + h * 128) * MTOK + tokb, MTOK,
                                    c.tabs + h * TABN, nullptr, q0, 0, t_hi, 1 << 24, c2, oa, ltab);
    { int tid_s = threadIdx.x; asm volatile("" : "+v"(tid_s)); float* st = c.stash + (size_t)blockIdx.x * 512 + tid_s; asm volatile("" : "+v"(st));
#pragma unroll
      for (int dt = 0; dt < 4; ++dt)
#pragma unroll
          for (int r = 0; r < 16; ++r) st[(size_t)(dt * 16 + r) * c.nthr] = oa[dt][r];
      asm volatile("" ::: "memory"); }
    attn_pass<64, 128, true, false, 128>(lds, c.P + (tokb + q0) * PW + P_AQ + h * 128 + 64, PW, c.P + tokb * PW + P_AK + h * 128 + 64, PW, c.VT + (size_t)(V_A + h * 128) * MTOK + tokb, MTOK,
                                    c.tabs + h * TABN, nullptr, q0, 0, t_hi, 1 << 24, c2, ob, false);
    int l_o = c.l; asm volatile("" : "+s"(l_o));
    const float lam = c.lamv[l_o], lam_init = lam_init_of(l_o); const float* subln = c.subln_base + l_o * 128;
    int tid_o = threadIdx.x; asm volatile("" : "+v"(tid_o));
    const int lane = tid_o & 63, r32 = lane & 31;
    { const float* st = c.stash + (size_t)blockIdx.x * 512 + tid_o; asm volatile("" : "+v"(st) :: "memory");
#pragma unroll
      for (int dt = 0; dt < 4; ++dt)
#pragma unroll
          for (int r = 0; r < 16; ++r) oa[dt][r] = st[(size_t)(dt * 16 + r) * c.nthr]; }
    float ss[16];
#pragma unroll
    for (int r = 0; r < 16; ++r) { float s = 0.f;
#pragma unroll
        for (int dt = 0; dt < 4; ++dt) { const float v = oa[dt][r] - lam * ob[dt][r]; oa[dt][r] = v; s += v * v; }
        ss[r] = s; }
#pragma unroll
    for (int r = 0; r < 16; ++r) {
#pragma unroll
        for (int o = 1; o < 32; o <<= 1) ss[r] += __shfl_xor(ss[r], o);
        ss[r] = (1.0f - lam_init) / sqrtf(ss[r] * (1.f / 128.f) + EPSN); }
#pragma unroll
    for (int dt = 0; dt < 4; ++dt) { const float g = subln[dt * 32 + r32];
#pragma unroll
        for (int r = 0; r < 16; ++r) oa[dt][r] = oa[dt][r] * ss[r] * g; }
    attn_store<128>(oa, c.MIX + (tokb + q0) * DM + h * 128, DM);
}
__device__ __forceinline__ void unitB(unsigned char* lds, const MixCtx& c, int b, int h, int qb, bool ltab) {
    const int q0 = qb * 256; const size_t tokb = (size_t)b * SEQ; const int t_hi = (q0 + 256) / 128; int t_lo = (q0 - 2048) / 128; if (t_lo < 0) t_lo = 0;
    f32x16 o[2];
    attn_pass<64, 64, true, false, 128>(lds, c.P + (tokb + q0) * PW + P_BQ + h * 64, PW, c.P + tokb * PW + P_BK + h * 64, PW, c.VT + (size_t)(V_B + h * 64) * MTOK + tokb, MTOK,
                                   c.tabs + (4 + h) * TABN, nullptr, q0, t_lo, t_hi, 2048, 0.125f * LOG2E, o, ltab);
    attn_store<64>(o, c.MIX + (tokb + q0) * DM + 512 + h * 64, DM);
}
__device__ __forceinline__ void unitC(unsigned char* lds, const MixCtx& c, int b, int h, int qb, bool ltab) {
    const int q0 = qb * 256; const size_t tokb = (size_t)b * SEQ; const int t_hi = (q0 + 256) / 128;
    f32x16 o[2];
    attn_pass<64, 64, true, true, 128>(lds, c.P + (tokb + q0) * PW + P_CQ + h * 64, PW, c.P + tokb * PW + P_CK + h * 64, PW, c.VT + (size_t)(V_C + h * 64) * MTOK + tokb, MTOK,
                                  c.tabs + (8 + h) * TABN, c.bits + (tokb + q0) * 128, q0, 0, t_hi, 1 << 24, 0.125f * LOG2E, o, ltab);
    attn_store<64>(o, c.MIX + (tokb + q0) * DM + 768 + h * 64, DM);
}
__device__ __forceinline__ void unitM(unsigned char* lds, const bf16_t* QM, const bf16_t* MK, const bf16_t* MVT, bf16_t* MIX, int l, int b, int h, int half, int qb) {
    const int q0 = qb * 256; const size_t tokb = (size_t)b * SEQ;
    f32x16 o[4];
    attn_pass<256, 128, false, false, 64>(lds, QM + (tokb + q0) * DM + h * 256, DM, MK + (size_t)(b * MEMLEN) * 4096 + l * 1024 + h * 256, 4096,
                                      MVT + (size_t)(l * 1024 + h * 256 + half * 128) * MMEM + b * MEMLEN, MMEM, nullptr, nullptr, q0, 0, MEMLEN / 64, 1 << 24, 0.0625f * LOG2E, o, false);
    attn_store<128>(o, MIX + (tokb + q0) * DM + h * 256 + half * 128, DM);
}

__device__ __forceinline__ void conv_fix_phase(const bf16_t* Fb, const bf16_t* Hb, bf16_t* G, const float* cw, const float* cb, int gtid, int nthr) {
    constexpr int CG = FF / 8, NSEG = MTOK / 64;
    const int nitems = NSEG * 2 * CG;
    for (int it = gtid; it < nitems; it += nthr) { const int cgi = it % CG, rest = it / CG, i = rest & 1, sg = rest >> 1, c0 = cgi * 8;
        const bool has = ((sg * 64) & (SEQ - 1)) != 0;
        const u32x4v z = (u32x4v){0u, 0u, 0u, 0u};
        const u32x4v u0g = *(const u32x4v*)(Fb + ((size_t)sg * 2 + i) * FF2 + c0), u0v = *(const u32x4v*)(Fb + ((size_t)sg * 2 + i) * FF2 + FF + c0);
        u32x4v p1g = z, p1v = z, p2g = z, p2v = z;
        if (i == 0) { if (has) { p1g = *(const u32x4v*)(Hb + ((size_t)(sg - 1) * 2 + 1) * FF2 + c0); p1v = *(const u32x4v*)(Hb + ((size_t)(sg - 1) * 2 + 1) * FF2 + FF + c0);
                                 p2g = *(const u32x4v*)(Hb + ((size_t)(sg - 1) * 2) * FF2 + c0); p2v = *(const u32x4v*)(Hb + ((size_t)(sg - 1) * 2) * FF2 + FF + c0); } }
        else { p1g = *(const u32x4v*)(Fb + ((size_t)sg * 2) * FF2 + c0); p1v = *(const u32x4v*)(Fb + ((size_t)sg * 2) * FF2 + FF + c0);
               if (has) { p2g = *(const u32x4v*)(Hb + ((size_t)(sg - 1) * 2 + 1) * FF2 + c0); p2v = *(const u32x4v*)(Hb + ((size_t)(sg - 1) * 2 + 1) * FF2 + FF + c0); } }
        float og[8];
#pragma unroll
        for (int e = 0; e < 8; ++e) { const int w = e >> 1, sh = (e & 1) * 16;
            const float a2 = __builtin_bit_cast(float, ((p2g[w] >> sh) & 0xffffu) << 16), a1 = __builtin_bit_cast(float, ((p1g[w] >> sh) & 0xffffu) << 16), a0 = __builtin_bit_cast(float, ((u0g[w] >> sh) & 0xffffu) << 16);
            const float b2 = __builtin_bit_cast(float, ((p2v[w] >> sh) & 0xffffu) << 16), b1 = __builtin_bit_cast(float, ((p1v[w] >> sh) & 0xffffu) << 16), b0 = __builtin_bit_cast(float, ((u0v[w] >> sh) & 0xffffu) << 16);
            const float cgate = cb[c0 + e] + cw[c0 + e] * a2 + cw[FF2 + c0 + e] * a1 + cw[2 * FF2 + c0 + e] * a0;
            const float cval = cb[FF + c0 + e] + cw[FF + c0 + e] * b2 + cw[FF2 + FF + c0 + e] * b1 + cw[2 * FF2 + FF + c0 + e] * b0;
            og[e] = cgate / (1.0f + __expf(-cgate)) * cval; }
        u32x4v w; w.x = cvtpk(og[0], og[1]); w.y = cvtpk(og[2], og[3]); w.z = cvtpk(og[4], og[5]); w.w = cvtpk(og[6], og[7]);
        *(u32x4v*)(G + ((size_t)sg * 64 + i) * FF + c0) = w; }
}

#define RLX_AGENT __ATOMIC_RELAXED, __HIP_MEMORY_SCOPE_AGENT
struct XcdBarrier { unsigned* bar; unsigned x; volatile LAS unsigned* st; };
#define XB_TMO      128
#define XB_XCNT(j)  (256  + 64 * (j))
#define XB_XSUB(j)  (1280 + 64 * (j))
#define XB_XGEN(j)  (2304 + 64 * (j))
#define XB_TOP      3328
#define XB_TOPGEN   3392
#define XCD_BAR_WORDS 3456
#define XB_SPIN_CAP (1u << 18)

__device__ __forceinline__ unsigned xb_ld(unsigned* p)              { return __hip_atomic_load(p, __ATOMIC_RELAXED, __HIP_MEMORY_SCOPE_AGENT); }
__device__ __forceinline__ unsigned xb_add(unsigned* p, unsigned v) { return __hip_atomic_fetch_add(p, v, __ATOMIC_RELAXED, __HIP_MEMORY_SCOPE_AGENT); }
__device__ __forceinline__ unsigned xb_xcc_id() { return (unsigned)__builtin_amdgcn_s_getreg((3 << 11) | 20) & 0xFu; }
#define XB_SPIN(cond, bar) do { unsigned _sp = 0; while (cond) { __builtin_amdgcn_s_sleep(0); \
    if ((++_sp & 255u) == 0u) { if (xb_ld(&(bar)[XB_TMO])) break; if (_sp > XB_SPIN_CAP) { atomicAdd(&(bar)[XB_TMO], 1u); break; } } } } while (0)

__device__ __forceinline__ XcdBarrier xcd_barrier_post(unsigned* bar, volatile LAS unsigned* st) {
    XcdBarrier b; b.bar = bar; b.x = xb_xcc_id(); b.st = st;
    if (threadIdx.x == 0) (void)xb_add(&bar[XB_XCNT(b.x)], 1u);
    return b;
}
__device__ __forceinline__ void xcd_barrier_complete(unsigned* bar, unsigned x, unsigned& nloc, unsigned& nx) {
    const unsigned G = gridDim.x * gridDim.y * gridDim.z;
    unsigned sum, cnt, mine, sp = 0u;
    for (;;) {
        sum = 0u; cnt = 0u; mine = 0u;
#pragma unroll
        for (unsigned j = 0; j < 16; ++j) { const unsigned c = xb_ld(&bar[XB_XCNT(j)]); sum += c; cnt += (c > 0u) ? 1u : 0u; mine = (j == x) ? c : mine; }
        if (sum == G) break;
        __builtin_amdgcn_s_sleep(1);
        if ((++sp & 255u) == 0u) { if (xb_ld(&bar[XB_TMO])) break; if (sp > XB_SPIN_CAP) { atomicAdd(&bar[XB_TMO], 1u); break; } }
    }
    nloc = mine > 0u ? mine : 1u; nx = cnt > 0u ? cnt : 1u;
}

__device__ __forceinline__ void xcd_barrier(const XcdBarrier& b) {
    asm volatile("s_waitcnt vmcnt(0)" ::: "memory");
    __syncthreads();
    if (threadIdx.x == 0) {
        unsigned* bar = b.bar;
        __builtin_amdgcn_s_waitcnt(0);
        unsigned nloc = b.st[0], nx = b.st[1];
        if (nloc == 0u) { xcd_barrier_complete(bar, b.x, nloc, nx); b.st[0] = nloc; b.st[1] = nx; }
        const unsigned old = xb_add(&bar[XB_XSUB(b.x)], 1u);
        const unsigned gen = old / nloc;
        if (old + 1u == (gen + 1u) * nloc) {
            __builtin_amdgcn_fence(__ATOMIC_RELEASE, "agent");
            asm volatile("s_waitcnt vmcnt(0)" ::: "memory");
            const unsigned og = xb_add(&bar[XB_TOP], 1u);
            const unsigned tg = og / nx;
            if (og + 1u == (tg + 1u) * nx) xb_add(&bar[XB_TOPGEN], 1u);
            else XB_SPIN(xb_ld(&bar[XB_TOPGEN]) == tg, bar);
            __builtin_amdgcn_fence(__ATOMIC_ACQUIRE, "agent");
            xb_add(&bar[XB_XGEN(b.x)], 1u);
            asm volatile("s_waitcnt vmcnt(0)" ::: "memory");
        } else {
            XB_SPIN(xb_ld(&bar[XB_XGEN(b.x)]) == gen, bar);
            __builtin_amdgcn_fence(__ATOMIC_ACQUIRE, "agent");
            asm volatile("s_waitcnt vmcnt(0)" ::: "memory");
        }
    }
    __syncthreads();
}

template <class Epi>
__device__ __forceinline__ void run_gemm(LAS unsigned char* ldsl, const bf16_t* A, const bf16_t* Bt, int M, int N, int K, const Epi& E) {
    pg8::Gemm g{A, Bt, M, N, K}; pg8::StaticOrder S; S.init(M, N, (int)gridDim.x, (int)blockIdx.x);
    pg8::gemm_phase<Epi, pg8::StaticOrder, true, true>(ldsl, g, S, E);
}

struct Args { const float* in[22]; float* out; unsigned char* ws; };

__global__ void __launch_bounds__(512, 2) fwd_kernel(Args a) {
    extern __shared__ __attribute__((aligned(16))) unsigned char lds[];
    cg::grid_group grid = cg::this_grid();
    LAS unsigned char* ldsl = (LAS unsigned char*)lds;
    const int G = gridDim.x, cb_ = blockIdx.x, NGW = G * 8, NTHR = G * 512;
    { volatile LAS unsigned* stw = (volatile LAS unsigned*)(ldsl + LDS_BYTES - 64); if (threadIdx.x < 16) stw[threadIdx.x] = 0u; }
    __syncthreads();
    (void)xcd_barrier_post((unsigned*)(a.ws + WS_BAR), (volatile LAS unsigned*)(ldsl + LDS_BYTES - 64));
#define GSYNC() do { XcdBarrier b_; b_.bar = (unsigned*)(a.ws + WS_BAR); b_.x = xb_xcc_id(); b_.st = (volatile LAS unsigned*)(ldsl + LDS_BYTES - 64); xcd_barrier(b_); } while (0)
#define FRESH_TID() ({ int t_ = threadIdx.x; asm volatile("" : "+v"(t_)); t_; })
#define NORM_ROWS(src, dst, nrows) do { const int t_ = FRESH_TID(); norm_rows(src, dst, nrows, cb_ * 8 + (t_ >> 6), NGW, t_ & 63); } while (0)
    unsigned char* ws = a.ws;
    const float* x_in = a.in[0]; float* X = a.out;
    float* lamv = (float*)(ws + WS_LAM); float* tabs = (float*)(ws + WS_TAB);
    bf16_t* WT = (bf16_t*)(ws + WS_WT);
    bf16_t* XH = (bf16_t*)(ws + WS_XH); bf16_t* MIX = (bf16_t*)(ws + WS_MIX); bf16_t* P = (bf16_t*)(ws + WS_P); bf16_t* VT = (bf16_t*)(ws + WS_VT);
    unsigned* BITS = (unsigned*)(ws + WS_BITS); bf16_t* MEMK = (bf16_t*)(ws + WS_MEMK); bf16_t* MEMVT = (bf16_t*)(ws + WS_MEMVT); bf16_t* MEMH = (bf16_t*)(ws + WS_MEMH);
    float* SS0 = (float*)(ws + WS_SS); float* SS1 = SS0 + (size_t)MTOK * 16; float* SS2 = SS1 + (size_t)MTOK * 16;
    bf16_t* GB = (bf16_t*)(ws + WS_G); bf16_t* FB = (bf16_t*)(ws + WS_FB); bf16_t* HB = (bf16_t*)(ws + WS_HB); bf16_t* QM = (bf16_t*)(ws + WS_QM);
    bf16_t* wt_in = (bf16_t*)((unsigned char*)WT + WT_IN); bf16_t* wt_out = (bf16_t*)((unsigned char*)WT + WT_OUT); bf16_t* wt_mq = (bf16_t*)((unsigned char*)WT + WT_MQ);
    bf16_t* wt_mo = (bf16_t*)((unsigned char*)WT + WT_MO); bf16_t* wt_mkv = (bf16_t*)((unsigned char*)WT + WT_MKV); bf16_t* wt_up = (bf16_t*)((unsigned char*)WT + WT_UP); bf16_t* wt_dn = (bf16_t*)((unsigned char*)WT + WT_DN);

    {
        const int tid = FRESH_TID(), lane = tid & 63, wave = __builtin_amdgcn_readfirstlane(tid >> 6), gw = cb_ * 8 + wave, gtid = cb_ * 512 + tid;
        float* scr = (float*)(lds + wave * 8448);
#pragma unroll 1
        for (int it = gw; it < NLAYER * 8704; it += NGW) { const int l = it / 8704; int r = it - l * 8704;
            if (r < 1920) { conv_one(a.in[4] + (size_t)l * DM * NIN, DM, NIN, 0, NIN, a.in[3] + l * DM, wt_in + (size_t)l * NINP * DM, NINP, 1, r, scr, lane); continue; } r -= 1920;
            if (r < 512) { conv_one(a.in[10] + (size_t)l * DM * DM, DM, DM, 0, DM, nullptr, wt_out + (size_t)l * DM * DM, DM, 0, r, scr, lane); continue; } r -= 512;
            if (r < 512) { conv_one(a.in[13] + (size_t)l * DM * DM, DM, DM, 0, DM, a.in[11] + l * DM, wt_mq + (size_t)l * DM * DM, DM, 0, r, scr, lane); continue; } r -= 512;
            if (r < 512) { conv_one(a.in[15] + (size_t)l * DM * DM, DM, DM, 0, DM, nullptr, wt_mo + (size_t)l * DM * DM, DM, 0, r, scr, lane); continue; } r -= 512;
            if (r < 512) { conv_one(a.in[14] + (size_t)l * DM * 2048, DM, 2048, 0, 1024, a.in[12] + l * DM, wt_mkv + (size_t)(l * 1024) * DM, 1024, 0, r, scr, lane); continue; } r -= 512;
            if (r < 512) { conv_one(a.in[14] + (size_t)l * DM * 2048, DM, 2048, 1024, 1024, a.in[12] + l * DM, wt_mkv + (size_t)(4096 + l * 1024) * DM, 1024, 0, r, scr, lane); continue; } r -= 512;
            if (r < 2816) { conv_one(a.in[17] + (size_t)l * DM * FF2, DM, FF2, 0, FF2, a.in[16] + l * DM, wt_up + (size_t)l * FF2 * DM, FF2, 2, r, scr, lane); continue; } r -= 2816;
            conv_one(a.in[20] + (size_t)l * FF * DM, FF, DM, 0, DM, nullptr, wt_dn + (size_t)l * DM * FF, DM, 0, r, scr, lane);
        }
        for (int idx = gtid; idx < 12 * TABN; idx += NTHR) { const int h = idx / TABN, dist = (TABN - 1 - idx % TABN) - TABOFF; float v = NEGV;
            if (dist >= 0) { int bucket = dist;
                if (dist >= 16) { const float nf = (float)dist; const float t = logf(nf / 16.0f) / 4.852030263919617f * 16.0f; int lg = 16 + (int)t; bucket = lg < 31 ? lg : 31; }
                const float bias = a.in[2][bucket * 12 + h];
                if (h >= 4 && h < 8) { const int mult = (dist <= 128 ? 1 : 0) + (((dist & 3) == 0 && dist <= 512) ? 1 : 0) + (((dist & 15) == 0 && dist <= 2048) ? 1 : 0);
                    if (mult > 0) v = (bias + logf((float)mult)) * LOG2E; }
                else v = bias * LOG2E; }
            tabs[idx] = v; }
        if (cb_ == 0 && wave < NLAYER) { const int l = wave;
            const float s1 = wave_sum(a.in[5][l * 64 + lane] * a.in[6][l * 64 + lane]), s2 = wave_sum(a.in[7][l * 64 + lane] * a.in[8][l * 64 + lane]);
            if (lane == 0) lamv[l] = expf(s1) - expf(s2) + lam_init_of(l); }
        norm_rows(a.in[1], MEMH, MMEM, gw, NGW, lane);
        cast_rows(x_in, XH, (float*)(ws + WS_SS), MTOK, gw, NGW, lane);
    }
    grid.sync();
    { pg8::EpiStore E{MEMK, 4096, 0, MEMVT, MMEM, 16, 32, 4096, nullptr}; run_gemm(ldsl, MEMH, wt_mkv, MMEM, 8192, DM, E); }

#pragma unroll 1
    for (int l = 0; l < NLAYER; ++l) {
        { pg8::EpiStore E{P, PW, 1024, VT, MTOK, 0, 4, 0, SS0}; run_gemm(ldsl, XH, wt_in + (size_t)l * NINP * DM, MTOK, NINP, DM, E); }
        GSYNC();
        MixCtx mc{P, VT, MIX, tabs, BITS, a.in[9], lamv, l, (float*)(ws + WS_STASH), NTHR};
        for (int it = cb_; it < 4096; it += G) idx_unit(lds, P, it & 15, it >> 4, BITS);
        { int ph = -1; for (int it = cb_; it < 1024; it += G) { int b, h, qb; deal_unit(it, b, h, qb); unitA(lds, mc, b, h, qb, h != ph); ph = h; } }
        { int ph = -1; for (int it = cb_; it < 1024; it += G) { int b, h, qb; deal_unit(it, b, h, qb); unitB(lds, mc, b, h, qb, h != ph); ph = h; } }
        GSYNC();
        { int ph = -1; for (int it = cb_; it < 1024; it += G) { int b, h, qb; deal_unit(it, b, h, qb); unitC(lds, mc, b, h, qb, h != ph); ph = h; } }
        GSYNC();
        { pg8::EpiResid E{XH, DM, SS1}; run_gemm(ldsl, MIX, wt_out + (size_t)l * DM * DM, MTOK, DM, DM, E); }
        GSYNC();
        { pg8::EpiStore E{QM, DM, 0, nullptr, 0, 0, 0, 0, SS1}; run_gemm(ldsl, XH, wt_mq + (size_t)l * DM * DM, MTOK, DM, DM, E); }
        GSYNC();
        for (int it = cb_; it < 2048; it += G) { const int xcd_ = it & 7, jj_ = ((it >> 3) & 31) * 8 + (it >> 8); const int qb = jj_ & 15, rest = xcd_ * 16 + (jj_ >> 4);     unitM(lds, QM, MEMK, MEMVT, MIX, l, rest >> 3, (rest >> 1) & 3, rest & 1, qb); }
        GSYNC();
        { pg8::EpiResid E{XH, DM, SS2}; run_gemm(ldsl, MIX, wt_mo + (size_t)l * DM * DM, MTOK, DM, DM, E); }
        GSYNC();
        { pg8::EpiConv E{GB, FB, HB, a.in[18] + (size_t)l * 3 * FF2, a.in[19] + (size_t)l * FF2, SS2}; run_gemm(ldsl, XH, wt_up + (size_t)l * FF2 * DM, MTOK, FF2, DM, E); }
        GSYNC();
        { const int t_ = FRESH_TID(); conv_fix_phase(FB, HB, GB, a.in[18] + (size_t)l * 3 * FF2, a.in[19] + (size_t)l * FF2, cb_ * 512 + t_, NTHR); }
        GSYNC();
        { pg8::EpiResid E{XH, DM, SS0}; run_gemm(ldsl, GB, wt_dn + (size_t)l * DM * FF, MTOK, DM, FF, E); }
        GSYNC();
    }
    { const int t_ = FRESH_TID(); final_rows(XH, X, a.in[21], cb_ * 8 + (t_ >> 6), NGW, t_ & 63); }
}

extern "C" void kernel_launch(void* const* d_in, const int* in_sizes, int n_in, void* d_out, int out_size, void* d_ws, size_t ws_size, hipStream_t stream) {
    static int grid_blocks = 0;
    if (grid_blocks == 0) {
        if (n_in != 22 || out_size != MTOK * DM || ws_size < WS_END) { fprintf(stderr, "kernel_launch: unexpected shapes (n_in %d out %d ws %zu)\n", n_in, out_size, ws_size); grid_blocks = -1; return; }
        int dev = 0, cus = 0, per_cu = 0;
        hipGetDevice(&dev);
        hipDeviceGetAttribute(&cus, hipDeviceAttributeMultiprocessorCount, dev);
        if (hipFuncSetAttribute((const void*)fwd_kernel, hipFuncAttributeMaxDynamicSharedMemorySize, LDS_BYTES) != hipSuccess) { fprintf(stderr, "kernel_launch: hipFuncSetAttribute failed\n"); }
        if (hipOccupancyMaxActiveBlocksPerMultiprocessor(&per_cu, (const void*)fwd_kernel, 512, LDS_BYTES) != hipSuccess || per_cu < 1) { fprintf(stderr, "kernel_launch: occupancy query %d\n", per_cu); per_cu = 1; }
        (void)hipGetLastError();
        grid_blocks = cus * per_cu;
    }
    if (grid_blocks < 0) return;
    if (hipMemsetAsync((char*)d_ws + WS_BAR, 0, WS_BAR_BYTES, stream) != hipSuccess) { fprintf(stderr, "kernel_launch: memset failed\n"); return; }
    Args a{};
    for (int i = 0; i < 22; ++i) a.in[i] = (const float*)d_in[i];
    a.out = (float*)d_out; a.ws = (unsigned char*)d_ws;
    void* args[] = {&a};
    hipError_t e = hipLaunchCooperativeKernel((const void*)fwd_kernel, dim3(grid_blocks), dim3(512), args, LDS_BYTES, stream);
    if (e != hipSuccess) fprintf(stderr, "kernel_launch: cooperative launch failed: %s (grid %d)\n", hipGetErrorString(e), grid_blocks);
}
```
